# Optimizing an MI355X kernel written in HIP

```python
import jax
import jax.numpy as jnp
from jax import lax
import numpy as np

D_MODEL = 2048
BATCH = 4
SEQ = 4096
DEPTH = 2

HEAD_DIM = 128
MOBA_HEADS = D_MODEL // (2 * HEAD_DIM)
FOX_HEADS = D_MODEL // (2 * HEAD_DIM)
MOBA_WIDTH = MOBA_HEADS * HEAD_DIM
FOX_WIDTH = FOX_HEADS * HEAD_DIM
MIX_WIDTH = MOBA_WIDTH + FOX_WIDTH
IN_WIDTH = 3 * MOBA_WIDTH + 3 * FOX_WIDTH + FOX_HEADS
MOBA_BLOCK = 256
MOBA_TOPK = 3
MOBA_Q_CHUNK = 32
FOX_Q_CHUNK = 128
ROPE_THETA = 10000.0
D_FF = (7 * D_MODEL) // 2
N_EXPERTS = 8
TOP_K = 2
EPS = 1e-6
F32 = jnp.float32

kernel_name = 'hybrid_moba_fox_adaln_moe_block'


def rmsnorm(x, g):
    x32 = x.astype(F32)
    y = x32 * lax.rsqrt(jnp.mean(x32 * x32, axis=-1, keepdims=True) + EPS)
    return (y * g.astype(F32)).astype(x.dtype)


def rope_tables(seq_len):
    inv = ROPE_THETA ** (-jnp.arange(0, HEAD_DIM, 2, dtype=F32) / HEAD_DIM)
    ang = jnp.arange(seq_len, dtype=F32)[:, None] * inv[None, :]
    return jnp.cos(ang), jnp.sin(ang)


def apply_rope(t, cos, sin):
    t32 = t.astype(F32)
    t1, t2 = jnp.split(t32, 2, axis=-1)
    return jnp.concatenate([t1 * cos - t2 * sin, t2 * cos + t1 * sin], axis=-1).astype(t.dtype)


def to_heads(t, n_heads):
    b, s, _ = t.shape
    return t.reshape(b, s, n_heads, HEAD_DIM).transpose(0, 2, 1, 3)


def from_heads(t):
    b, h, s, d = t.shape
    return t.transpose(0, 2, 1, 3).reshape(b, s, h * d)


def moba_attention(q, k, v):
    b, h, s, dh = q.shape
    nb = -(-s // MOBA_BLOCK)
    pad = nb * MOBA_BLOCK - s
    kp = jnp.pad(k, ((0, 0), (0, 0), (0, pad), (0, 0)))
    vp = jnp.pad(v, ((0, 0), (0, 0), (0, pad), (0, 0)))
    kb = kp.reshape(b, h, nb, MOBA_BLOCK, dh)
    vb = vp.reshape(b, h, nb, MOBA_BLOCK, dh)
    k_mean = jnp.mean(kb.astype(F32), axis=3)
    gate = jnp.einsum('bhsd,bhnd->bhsn', q.astype(F32), k_mean)
    qblk = jnp.arange(s) // MOBA_BLOCK
    past = jnp.arange(nb)[None, :] < qblk[:, None]
    gate = jnp.where(past, gate, -jnp.inf)
    kk = min(MOBA_TOPK, nb)
    _, sel = lax.top_k(gate, kk)
    valid = sel < qblk[:, None]
    n_chunks = s // MOBA_Q_CHUNK
    q_ch = q.reshape(b, h, n_chunks, MOBA_Q_CHUNK, dh).transpose(2, 0, 1, 3, 4)
    sel_ch = sel.reshape(b, h, n_chunks, MOBA_Q_CHUNK, kk).transpose(2, 0, 1, 3, 4)
    val_ch = valid.reshape(b, h, n_chunks, MOBA_Q_CHUNK, kk).transpose(2, 0, 1, 3, 4)
    scale = dh ** -0.5
    b_idx = jnp.arange(b)[:, None, None, None]
    h_idx = jnp.arange(h)[None, :, None, None]

    def chunk_fn(args):
        ci, q_c, sel_c, val_c = args
        start = ci * MOBA_Q_CHUNK
        blk = start // MOBA_BLOCK
        k_sel = kb[b_idx, h_idx, sel_c]
        v_sel = vb[b_idx, h_idx, sel_c]
        s_sel = jnp.einsum('bhqd,bhqjnd->bhqjn', q_c, k_sel, preferred_element_type=F32) * scale
        s_sel = jnp.where(val_c[..., None], s_sel, -jnp.inf).reshape(b, h, MOBA_Q_CHUNK, kk * MOBA_BLOCK)
        k_own = lax.dynamic_slice_in_dim(kp, blk * MOBA_BLOCK, MOBA_BLOCK, axis=2)
        v_own = lax.dynamic_slice_in_dim(vp, blk * MOBA_BLOCK, MOBA_BLOCK, axis=2)
        s_own = jnp.einsum('bhqd,bhnd->bhqn', q_c, k_own, preferred_element_type=F32) * scale
        qpos = start + jnp.arange(MOBA_Q_CHUNK)
        kpos = blk * MOBA_BLOCK + jnp.arange(MOBA_BLOCK)
        s_own = jnp.where(kpos[None, :] <= qpos[:, None], s_own, -jnp.inf)
        p = jax.nn.softmax(jnp.concatenate([s_sel, s_own], axis=-1), axis=-1)
        p_sel = p[..., :kk * MOBA_BLOCK].reshape(b, h, MOBA_Q_CHUNK, kk, MOBA_BLOCK).astype(v.dtype)
        p_own = p[..., kk * MOBA_BLOCK:].astype(v.dtype)
        return (jnp.einsum('bhqjn,bhqjnd->bhqd', p_sel, v_sel)
                + jnp.einsum('bhqn,bhnd->bhqd', p_own, v_own))

    out = lax.map(chunk_fn, (jnp.arange(n_chunks), q_ch, sel_ch, val_ch))
    return out.transpose(1, 2, 0, 3, 4).reshape(b, h, s, dh)


def forgetting_attention(q, k, v, log_f):
    b, h, s, dh = q.shape
    cum = lax.cumsum(log_f, axis=2)
    n_chunks = s // FOX_Q_CHUNK
    q_ch = q.reshape(b, h, n_chunks, FOX_Q_CHUNK, dh).transpose(2, 0, 1, 3, 4)
    c_ch = cum.reshape(b, h, n_chunks, FOX_Q_CHUNK).transpose(2, 0, 1, 3)
    kpos = jnp.arange(s)
    scale = dh ** -0.5

    def chunk_fn(args):
        ci, q_c, c_c = args
        sc = jnp.einsum('bhqd,bhkd->bhqk', q_c, k, preferred_element_type=F32) * scale
        sc = sc + c_c[..., None] - cum[:, :, None, :]
        qpos = ci * FOX_Q_CHUNK + jnp.arange(FOX_Q_CHUNK)
        sc = jnp.where(kpos[None, :] <= qpos[:, None], sc, -jnp.inf)
        p = jax.nn.softmax(sc, axis=-1).astype(v.dtype)
        return jnp.einsum('bhqk,bhkd->bhqd', p, v)

    out = lax.map(chunk_fn, (jnp.arange(n_chunks), q_ch, c_ch))
    return out.transpose(1, 2, 0, 3, 4).reshape(b, h, s, dh)


def hybrid_mixer(h, w_in, forget_b, moba_out_g, fox_out_g, w_o, cos, sin):
    proj = jnp.einsum('bsd,de->bse', h, w_in)
    cuts = [MOBA_WIDTH, 2 * MOBA_WIDTH, 3 * MOBA_WIDTH,
            3 * MOBA_WIDTH + FOX_WIDTH, 3 * MOBA_WIDTH + 2 * FOX_WIDTH, 3 * MOBA_WIDTH + 3 * FOX_WIDTH]
    mq, mk, mv, fq, fk, fv, fz = jnp.split(proj, cuts, axis=-1)
    mq = apply_rope(to_heads(mq, MOBA_HEADS), cos, sin)
    mk = apply_rope(to_heads(mk, MOBA_HEADS), cos, sin)
    moba_o = from_heads(moba_attention(mq, mk, to_heads(mv, MOBA_HEADS)))
    log_f = jax.nn.log_sigmoid(fz.astype(F32) + forget_b.astype(F32)).transpose(0, 2, 1)
    fox_o = from_heads(forgetting_attention(to_heads(fq, FOX_HEADS), to_heads(fk, FOX_HEADS),
                                            to_heads(fv, FOX_HEADS), log_f))
    merged = jnp.concatenate([rmsnorm(moba_o, moba_out_g), rmsnorm(fox_o, fox_out_g)], axis=-1)
    return jnp.einsum('bse,ed->bsd', merged, w_o)


def swiglu(t, w_gate, w_up, w_down):
    return jnp.matmul(jax.nn.silu(jnp.matmul(t, w_gate)) * jnp.matmul(t, w_up), w_down)


def moe_swiglu(h, router_w, w_gate, w_up, w_down):
    b, s, d = h.shape
    t = h.reshape(b * s, d)
    logits = jnp.einsum('nd,de->ne', t, router_w, preferred_element_type=F32)
    top_v, top_i = lax.top_k(logits, TOP_K)
    top_w = jax.nn.softmax(top_v, axis=-1)
    comb = jnp.sum(jax.nn.one_hot(top_i, N_EXPERTS, dtype=F32) * top_w[..., None], axis=1)
    y = jnp.zeros_like(t)
    for e in range(N_EXPERTS):
        y = y + comb[:, e:e + 1].astype(t.dtype) * swiglu(t, w_gate[e], w_up[e], w_down[e])
    return y.reshape(b, s, d)


def setup_inputs(seed: int = 0) -> dict:
    key = jax.random.key(seed)
    ks = jax.random.split(key, 22)
    d = D_MODEL
    n_layers = DEPTH
    n_dense = (DEPTH + 1) // 2
    n_moe = DEPTH // 2

    def nrm(k, shape, fan_in, gain=1.0):
        return jax.random.normal(k, shape, F32) * (gain * fan_in ** -0.5)

    def gain(k, shape):
        return 1.0 + 0.1 * jax.random.normal(k, shape, F32)

    return {
        'x': jax.random.normal(ks[0], (BATCH, SEQ, d), F32),
        'c': jax.random.normal(ks[1], (BATCH, d), F32),
        'attn_norm_g': gain(ks[2], (n_layers, d)),
        'ada_w': nrm(ks[3], (n_layers, d, 6 * d), d, 0.5),
        'ada_b': 0.02 * jax.random.normal(ks[4], (n_layers, 6 * d), F32),
        'w_in': nrm(ks[5], (n_layers, d, IN_WIDTH), d),
        'forget_b': jax.random.uniform(ks[6], (n_layers, FOX_HEADS), F32, minval=2.0, maxval=6.0),
        'moba_out_g': gain(ks[7], (n_layers, MOBA_WIDTH)),
        'fox_out_g': gain(ks[8], (n_layers, FOX_WIDTH)),
        'w_o': nrm(ks[9], (n_layers, MIX_WIDTH, d), MIX_WIDTH),
        'ffn_norm_g': gain(ks[10], (n_layers, d)),
        'dense_w_gate': nrm(ks[11], (n_dense, d, D_FF), d),
        'dense_w_up': nrm(ks[12], (n_dense, d, D_FF), d),
        'dense_w_down': nrm(ks[13], (n_dense, D_FF, d), D_FF),
        'router_w': nrm(ks[14], (n_moe, d, N_EXPERTS), d),
        'moe_w_gate': nrm(ks[15], (n_moe, N_EXPERTS, d, D_FF), d),
        'moe_w_up': nrm(ks[16], (n_moe, N_EXPERTS, d, D_FF), d),
        'moe_w_down': nrm(ks[17], (n_moe, N_EXPERTS, D_FF, d), D_FF),
        'final_norm_g': gain(ks[18], (d,)),
    }


def reference(x, c, attn_norm_g, ada_w, ada_b, w_in, forget_b, moba_out_g, fox_out_g, w_o,
              ffn_norm_g, dense_w_gate, dense_w_up, dense_w_down, router_w, moe_w_gate,
              moe_w_up, moe_w_down, final_norm_g):
    seq_len = x.shape[1]
    cos, sin = rope_tables(seq_len)
    c_act = jax.nn.silu(c)
    for l in range(DEPTH):
        mod = (jnp.matmul(c_act, ada_w[l]) + ada_b[l])[:, None, :]
        sh_a, sc_a, g_a, sh_f, sc_f, g_f = jnp.split(mod, 6, axis=-1)
        h = rmsnorm(x, attn_norm_g[l]) * (1.0 + sc_a) + sh_a
        x = x + g_a * hybrid_mixer(h, w_in[l], forget_b[l], moba_out_g[l], fox_out_g[l], w_o[l], cos, sin)
        h = rmsnorm(x, ffn_norm_g[l]) * (1.0 + sc_f) + sh_f
        i = l // 2
        if l % 2 == 0:
            y = swiglu(h, dense_w_gate[i], dense_w_up[i], dense_w_down[i])
        else:
            y = moe_swiglu(h, router_w[i], moe_w_gate[i], moe_w_up[i], moe_w_down[i])
        x = x + g_f * y
    return rmsnorm(x, final_norm_g)
```

```cpp
#include <hip/hip_runtime.h>
#include <cstdio>
#include <cstdint>
#include <cmath>
namespace pg8 {
#define PG8_LAS __attribute__((address_space(3)))
typedef unsigned short bf16_t;
typedef short bf16x8 __attribute__((ext_vector_type(8)));
typedef float f32x4 __attribute__((ext_vector_type(4)));
typedef unsigned u32x4 __attribute__((ext_vector_type(4)));
constexpr int BM = 256, BK = 64, HALF = 128, HTB = HALF * BK * 2  , STAGE_BYTES = 8 * HTB, NXCD = 8, WGM = 8;

__host__ __device__ __forceinline__ int lds_byte(int r, int c) { const int st = (r >> 4) * 2 + (c >> 5), rr = r & 15, cc = c & 31, ob = rr * 64 + cc * 2; return st * 1024 + (ob ^ (((ob >> 9) & 1) << 5)); }
__host__ __device__ __forceinline__ void stage_rc(int b, int& R, int& C) { const int st = b / 1024, sb = b % 1024, swz = sb ^ (((sb >> 9) & 1) << 5); R = (st >> 1) * 16 + swz / 64; C = (st & 1) * 32 + (swz % 64) / 2; }
__host__ __device__ __forceinline__ int perm32(int rho) { const int n = rho >> 4, i = rho & 15; return 8 * (i >> 2) + 4 * n + (i & 3); }

struct Unit { int pm, pn, be, idx; unsigned koff; };
struct Gemm { const bf16_t* A; const bf16_t* Bt; int M, N, K; size_t bstride; int nt; };

struct StaticOrder {
    int nM, nN, nwg, G, c, wgm;
    __host__ __device__ void init(int M, int N, int G_, int c_, int wgm_ = WGM) { nM = M / BM; nN = N / BM; nwg = nM * nN; G = G_; c = c_; wgm = wgm_; }
    __host__ __device__ bool next(int i, Unit& u) const {
        const long L = (long)i * G + c; if (L >= nwg) return false;
        int wgid = (int)L; { const int q = nwg / NXCD, r = nwg % NXCD, xcd = wgid % NXCD, off = wgid / NXCD; wgid = (xcd < r ? xcd * (q + 1) : r * (q + 1) + (xcd - r) * q) + off; }
        const int nig = wgm * nN, gid = wgid / nig, fm = gid * wgm, gsz = (nM - fm) < wgm ? (nM - fm) : wgm;
        u.pm = fm + ((wgid % nig) % gsz); u.pn = (wgid % nig) / gsz; u.be = 0; u.idx = i; u.koff = 0u; return true;
    }
    __device__ __forceinline__ void a_ready(const Unit&) const {}
    __device__ __forceinline__ void done(const Unit&) const {}
};

__device__ __forceinline__ unsigned cvt_pk_bf16(float lo, float hi) { unsigned r; asm volatile("v_cvt_pk_bf16_f32 %0, %1, %2" : "=v"(r) : "v"(lo), "v"(hi)); return r; }
typedef float f32x2 __attribute__((ext_vector_type(2)));
typedef int i32x8 __attribute__((ext_vector_type(8)));
typedef int i32x4v __attribute__((ext_vector_type(4)));
__device__ __forceinline__ f32x4 mfma_fp8_128(bf16x8 b0, bf16x8 b1, bf16x8 a0, bf16x8 a1, f32x4 c) {
    const i32x4v bl = __builtin_bit_cast(i32x4v, b0), bh = __builtin_bit_cast(i32x4v, b1), al = __builtin_bit_cast(i32x4v, a0), ah = __builtin_bit_cast(i32x4v, a1);
    const i32x8 B = {bl[0], bl[1], bl[2], bl[3], bh[0], bh[1], bh[2], bh[3]}, A = {al[0], al[1], al[2], al[3], ah[0], ah[1], ah[2], ah[3]};
    asm volatile("v_mfma_f32_16x16x128_f8f6f4 %0, %1, %2, %0" : "+v"(c) : "v"(B), "v"(A));
    return c;
}
__device__ __forceinline__ unsigned pk_fp8x4(float a, float b, float c, float d) { int w = 0; w = __builtin_amdgcn_cvt_pk_fp8_f32(a, b, w, false); w = __builtin_amdgcn_cvt_pk_fp8_f32(c, d, w, true); return (unsigned)w; }

struct EpiQKV {
    static constexpr bool PERM = true, AFTER_DRAIN = false, HAS_MID = false;
    bf16_t* O; int ldc; const float* ropeT; float* ksum;
    __device__ __forceinline__ void operator()(const f32x4 (&acc)[2][2][4][2], const Unit& u, int wr, int wc, int fr, int fq) const {
        const int row0 = u.pm * BM + wr * 64 + fr, col0 = u.pn * BM + wc * 32 + 8 * fq; const bool rope = u.pn < 8, ktile = u.pn >= 4 && u.pn < 8;
        float cs[16];
#pragma unroll
        for (int i = 0; i < 16; ++i) cs[i] = 0.f;
#pragma unroll
        for (int ai = 0; ai < 2; ++ai)
#pragma unroll
            for (int m = 0; m < 4; ++m) { const int row = row0 + ai * HALF + m * 16; bf16_t* rowp = O + (size_t)row * ldc + col0;
                f32x4 c4 = {1.f, 1.f, 1.f, 1.f}, s4 = {0.f, 0.f, 0.f, 0.f};
                if (rope) { const float* rt = ropeT + ((size_t)(row & 4095) * 16 + (wc * 4 + fq)) * 8; c4 = *(const f32x4*)rt; s4 = *(const f32x4*)(rt + 4); }
#pragma unroll
                for (int bj = 0; bj < 2; ++bj) { f32x4 v0 = acc[ai][bj][m][0], v1 = acc[ai][bj][m][1];
                    if (rope) { const f32x4 t1 = v0, t2 = v1; v0 = t1 * c4 - t2 * s4; v1 = t2 * c4 + t1 * s4; }
                    if (ktile) {
#pragma unroll
                        for (int j = 0; j < 4; ++j) { cs[bj * 8 + j] += v0[j]; cs[bj * 8 + 4 + j] += v1[j]; } }
                    u32x4 w; w.x = cvt_pk_bf16(v0[0], v0[1]); w.y = cvt_pk_bf16(v0[2], v0[3]); w.z = cvt_pk_bf16(v1[0], v1[1]); w.w = cvt_pk_bf16(v1[2], v1[3]);
                    *(u32x4*)(rowp + bj * HALF) = w; } }
        if (ktile) {
            float a8[8], a4[4], a2[2], a1;
            const bool b3 = (fr & 8) != 0, b2 = (fr & 4) != 0, b1 = (fr & 2) != 0, b0 = (fr & 1) != 0;
#pragma unroll
            for (int i = 0; i < 8; ++i) { const float send = b3 ? cs[i] : cs[i + 8], keep = b3 ? cs[i + 8] : cs[i]; a8[i] = keep + __shfl_xor(send, 8); }
#pragma unroll
            for (int i = 0; i < 4; ++i) { const float send = b2 ? a8[i] : a8[i + 4], keep = b2 ? a8[i + 4] : a8[i]; a4[i] = keep + __shfl_xor(send, 4); }
#pragma unroll
            for (int i = 0; i < 2; ++i) { const float send = b1 ? a4[i] : a4[i + 2], keep = b1 ? a4[i + 2] : a4[i]; a2[i] = keep + __shfl_xor(send, 2); }
            { const float send = b0 ? a2[0] : a2[1], keep = b0 ? a2[1] : a2[0]; a1 = keep + __shfl_xor(send, 1); }
            const int bj = fr >> 3, n = (fr >> 2) & 1, j = fr & 3;
            const int hd = (u.pn - 4) * 2 + bj, dcol = wc * 32 + 8 * fq + 4 * n + j;
            float* dst = ksum + (((size_t)(u.pm >> 4) * 8 + hd) * 16 + (u.pm & 15)) * 128 + dcol;
            __hip_atomic_fetch_add(dst, a1, __ATOMIC_RELAXED, __HIP_MEMORY_SCOPE_AGENT);
        }
    }
};
struct EpiResid {
    static constexpr bool PERM = false, AFTER_DRAIN = false, HAS_MID = false;
    const float* xin; float* out; const float* gate; float sc;
    __device__ __forceinline__ void operator()(const f32x4 (&acc)[2][2][4][2], const Unit& u, int wr, int wc, int fr, int fq) const {
        const int row0 = u.pm * BM + wr * 64 + fr, col0 = u.pn * BM + wc * 32 + 4 * fq; const float* gp = gate + (size_t)(u.pm >> 4) * 12288 + col0;
        f32x4 gv[2][2];
#pragma unroll
        for (int bj = 0; bj < 2; ++bj)
#pragma unroll
            for (int n = 0; n < 2; ++n) gv[bj][n] = *(const f32x4*)(gp + bj * HALF + n * 16) * sc;
#pragma unroll
        for (int ai = 0; ai < 2; ++ai) { f32x4 pre[4][2][2];
#pragma unroll
            for (int m = 0; m < 4; ++m) { const size_t off = (size_t)(row0 + ai * HALF + m * 16) * 2048 + col0;
#pragma unroll
                for (int bj = 0; bj < 2; ++bj)
#pragma unroll
                    for (int n = 0; n < 2; ++n) pre[m][bj][n] = *(const f32x4*)(xin + off + bj * HALF + n * 16); }
            __builtin_amdgcn_sched_barrier(0);
#pragma unroll
            for (int m = 0; m < 4; ++m) { const size_t off = (size_t)(row0 + ai * HALF + m * 16) * 2048 + col0;
#pragma unroll
                for (int bj = 0; bj < 2; ++bj)
#pragma unroll
                    for (int n = 0; n < 2; ++n) *(f32x4*)(out + off + bj * HALF + n * 16) = pre[m][bj][n] + gv[bj][n] * acc[ai][bj][m][n]; }
            __builtin_amdgcn_sched_barrier(0); }
    }
};
struct EpiResidN {
    static constexpr bool PERM = false, AFTER_DRAIN = false, HAS_MID = true;
    const float* xin; float* out; const float* gate; const PG8_LAS float* rs;
    __device__ __forceinline__ void mid(f32x4 (&acc)[2][2][4][2], const Unit& u, int wr, int wc, int fr, int fq) const {
        const PG8_LAS float* r = rs + (u.idx * 256 + wr * 64 + fr) * 2;
#pragma unroll
        for (int ai = 0; ai < 2; ++ai)
#pragma unroll
            for (int m = 0; m < 4; ++m) { const float ratio = r[(ai * HALF + m * 16) * 2];
#pragma unroll
                for (int bj = 0; bj < 2; ++bj)
#pragma unroll
                    for (int n = 0; n < 2; ++n) acc[ai][bj][m][n] = acc[ai][bj][m][n] * ratio; }
    }
    __device__ __forceinline__ void operator()(const f32x4 (&acc)[2][2][4][2], const Unit& u, int wr, int wc, int fr, int fq) const {
        const int row0 = u.pm * BM + wr * 64 + fr, col0 = u.pn * BM + wc * 32 + 4 * fq; const float* gp = gate + (size_t)(u.pm >> 4) * 12288 + col0;
        const PG8_LAS float* r = rs + (u.idx * 256 + wr * 64 + fr) * 2 + 1;
        f32x4 gv[2][2];
#pragma unroll
        for (int bj = 0; bj < 2; ++bj)
#pragma unroll
            for (int n = 0; n < 2; ++n) gv[bj][n] = *(const f32x4*)(gp + bj * HALF + n * 16);
#pragma unroll
        for (int ai = 0; ai < 2; ++ai) { f32x4 pre[4][2][2];
#pragma unroll
            for (int m = 0; m < 4; ++m) { const size_t off = (size_t)(row0 + ai * HALF + m * 16) * 2048 + col0;
#pragma unroll
                for (int bj = 0; bj < 2; ++bj)
#pragma unroll
                    for (int n = 0; n < 2; ++n) pre[m][bj][n] = *(const f32x4*)(xin + off + bj * HALF + n * 16); }
            __builtin_amdgcn_sched_barrier(0);
#pragma unroll
            for (int m = 0; m < 4; ++m) { const size_t off = (size_t)(row0 + ai * HALF + m * 16) * 2048 + col0; const float rf = r[(ai * HALF + m * 16) * 2];
#pragma unroll
                for (int bj = 0; bj < 2; ++bj)
#pragma unroll
                    for (int n = 0; n < 2; ++n) *(f32x4*)(out + off + bj * HALF + n * 16) = pre[m][bj][n] + gv[bj][n] * (acc[ai][bj][m][n] * rf); }
            __builtin_amdgcn_sched_barrier(0); }
    }
};
template <bool XF32, bool NRM>
struct EpiResidB {
    static constexpr bool PERM = true, AFTER_DRAIN = false, HAS_MID = NRM;
    const void* xin; bf16_t* out; const float* gate; float sc; const PG8_LAS float* rs;
    __device__ __forceinline__ void mid(f32x4 (&acc)[2][2][4][2], const Unit& u, int wr, int wc, int fr, int fq) const {
        const PG8_LAS float* r = rs + (u.idx * 256 + wr * 64 + fr) * 2;
#pragma unroll
        for (int ai = 0; ai < 2; ++ai)
#pragma unroll
            for (int m = 0; m < 4; ++m) { const float ratio = r[(ai * HALF + m * 16) * 2];
#pragma unroll
                for (int bj = 0; bj < 2; ++bj)
#pragma unroll
                    for (int n = 0; n < 2; ++n) acc[ai][bj][m][n] = acc[ai][bj][m][n] * ratio; }
    }
    __device__ __forceinline__ void operator()(const f32x4 (&acc)[2][2][4][2], const Unit& u, int wr, int wc, int fr, int fq) const {
        const int row0 = u.pm * BM + wr * 64 + fr, col0 = u.pn * BM + wc * 32 + 8 * fq; const float* gp = gate + (size_t)(u.pm >> 4) * 12288 + col0;
        const PG8_LAS float* r = rs + (u.idx * 256 + wr * 64 + fr) * 2 + 1;
        f32x4 gv[2][2];
#pragma unroll
        for (int bj = 0; bj < 2; ++bj)
#pragma unroll
            for (int n = 0; n < 2; ++n) gv[bj][n] = *(const f32x4*)(gp + bj * HALF + n * 4) * sc;
#pragma unroll
        for (int ai = 0; ai < 2; ++ai) { f32x4 pre[4][2][2]; u32x4 praw[4][2];
#pragma unroll
            for (int m = 0; m < 4; ++m) { const size_t off = (size_t)(row0 + ai * HALF + m * 16) * 2048 + col0;
#pragma unroll
                for (int bj = 0; bj < 2; ++bj) {
                    if (XF32) { pre[m][bj][0] = *(const f32x4*)((const float*)xin + off + bj * HALF); pre[m][bj][1] = *(const f32x4*)((const float*)xin + off + bj * HALF + 4); }
                    else praw[m][bj] = *(const u32x4*)((const bf16_t*)xin + off + bj * HALF); } }
            __builtin_amdgcn_sched_barrier(0);
#pragma unroll
            for (int m = 0; m < 4; ++m) { const size_t off = (size_t)(row0 + ai * HALF + m * 16) * 2048 + col0; float rf = 1.f; if (NRM) rf = r[(ai * HALF + m * 16) * 2];
#pragma unroll
                for (int bj = 0; bj < 2; ++bj) { f32x4 x0, x1, v0, v1;
                    if (XF32) { x0 = pre[m][bj][0]; x1 = pre[m][bj][1]; }
                    else { const u32x4 w = praw[m][bj];
                        x0 = (f32x4){__builtin_bit_cast(float, w.x << 16), __builtin_bit_cast(float, w.x & 0xffff0000u), __builtin_bit_cast(float, w.y << 16), __builtin_bit_cast(float, w.y & 0xffff0000u)};
                        x1 = (f32x4){__builtin_bit_cast(float, w.z << 16), __builtin_bit_cast(float, w.z & 0xffff0000u), __builtin_bit_cast(float, w.w << 16), __builtin_bit_cast(float, w.w & 0xffff0000u)}; }
                    if (NRM) { v0 = x0 + gv[bj][0] * (acc[ai][bj][m][0] * rf); v1 = x1 + gv[bj][1] * (acc[ai][bj][m][1] * rf); }
                    else { v0 = x0 + gv[bj][0] * acc[ai][bj][m][0]; v1 = x1 + gv[bj][1] * acc[ai][bj][m][1]; }
                    u32x4 w; w.x = cvt_pk_bf16(v0[0], v0[1]); w.y = cvt_pk_bf16(v0[2], v0[3]); w.z = cvt_pk_bf16(v1[0], v1[1]); w.w = cvt_pk_bf16(v1[2], v1[3]);
                    *(u32x4*)(out + off + bj * HALF) = w; } }
            __builtin_amdgcn_sched_barrier(0); }
    }
};
struct EpiSwiGLU {
    static constexpr bool PERM = true, AFTER_DRAIN = false, HAS_MID = false;
    bf16_t* O; int ldc;
    __device__ __forceinline__ void operator()(const f32x4 (&acc)[2][2][4][2], const Unit& u, int wr, int wc, int fr, int fq) const {
        const int row0 = u.pm * BM + wr * 64 + fr, col0 = u.pn * HALF + wc * 32 + 8 * fq;
#pragma unroll
        for (int ai = 0; ai < 2; ++ai)
#pragma unroll
            for (int m = 0; m < 4; ++m) { bf16_t* rowp = O + (size_t)(row0 + ai * HALF + m * 16) * ldc + col0; float a[8];
#pragma unroll
                for (int n = 0; n < 2; ++n)
#pragma unroll
                    for (int j = 0; j < 4; ++j) { const float g = acc[ai][0][m][n][j], up = acc[ai][1][m][n][j];
                        a[n * 4 + j] = g * __builtin_amdgcn_rcpf(1.0f + __builtin_amdgcn_exp2f(-1.4426950408889634f * g)) * up; }
                u32x4 w; w.x = cvt_pk_bf16(a[0], a[1]); w.y = cvt_pk_bf16(a[2], a[3]); w.z = cvt_pk_bf16(a[4], a[5]); w.w = cvt_pk_bf16(a[6], a[7]);
                *(u32x4*)rowp = w; }
    }
};
struct EpiSwiGLU8 {
    static constexpr bool PERM = true, AFTER_DRAIN = false, HAS_MID = false;
    unsigned char* O; int ldc; float sc;
    __device__ __forceinline__ void operator()(const f32x4 (&acc)[2][2][4][2], const Unit& u, int wr, int wc, int fr, int fq) const {
        const int row0 = u.pm * BM + wr * 64 + fr, col0 = u.pn * HALF + wc * 32 + 8 * fq; const float S = 1.0f / (sc * sc);
#pragma unroll
        for (int ai = 0; ai < 2; ++ai)
#pragma unroll
            for (int m = 0; m < 4; ++m) { unsigned char* rowp = O + (size_t)(row0 + ai * HALF + m * 16) * ldc + col0; float a[8];
#pragma unroll
                for (int n = 0; n < 2; ++n)
#pragma unroll
                    for (int j = 0; j < 4; j += 2) {
                        typedef float f32x2 __attribute__((ext_vector_type(2)));
                        const f32x2 g = {acc[ai][0][m][n][j], acc[ai][0][m][n][j + 1]}, up = {acc[ai][1][m][n][j], acc[ai][1][m][n][j + 1]};
                        const f32x2 t = g * (-1.4426950408889634f * sc); f32x2 e; e.x = __builtin_amdgcn_exp2f(t.x); e.y = __builtin_amdgcn_exp2f(t.y);
                        const f32x2 d = e * S + S; f32x2 r; r.x = __builtin_amdgcn_rcpf(d.x); r.y = __builtin_amdgcn_rcpf(d.y);
                        const f32x2 o = (g * up) * r; a[n * 4 + j] = o.x; a[n * 4 + j + 1] = o.y; }
                typedef unsigned u32x2 __attribute__((ext_vector_type(2)));
                u32x2 w; w.x = pk_fp8x4(a[0], a[1], a[2], a[3]); w.y = pk_fp8x4(a[4], a[5], a[6], a[7]);
                *(u32x2*)rowp = w; }
    }
};
struct EpiBf16S {
    static constexpr bool PERM = true, AFTER_DRAIN = false, HAS_MID = false;
    bf16_t* O; int ldc; float sc;
    __device__ __forceinline__ void operator()(const f32x4 (&acc)[2][2][4][2], const Unit& u, int wr, int wc, int fr, int fq) const {
        const int row0 = u.pm * BM + wr * 64 + fr, col0 = u.pn * BM + wc * 32 + 8 * fq;
#pragma unroll
        for (int ai = 0; ai < 2; ++ai)
#pragma unroll
            for (int m = 0; m < 4; ++m) { bf16_t* rowp = O + (size_t)(row0 + ai * HALF + m * 16) * ldc + col0;
#pragma unroll
                for (int bj = 0; bj < 2; ++bj) { const f32x4 v0 = acc[ai][bj][m][0] * sc, v1 = acc[ai][bj][m][1] * sc;
                    u32x4 w; w.x = cvt_pk_bf16(v0[0], v0[1]); w.y = cvt_pk_bf16(v0[2], v0[3]); w.z = cvt_pk_bf16(v1[0], v1[1]); w.w = cvt_pk_bf16(v1[2], v1[3]);
                    *(u32x4*)(rowp + bj * HALF) = w; } }
    }
};
struct EpiF32 {
    static constexpr bool PERM = false, AFTER_DRAIN = false, HAS_MID = false;
    float* out; float sc;
    __device__ __forceinline__ void operator()(const f32x4 (&acc)[2][2][4][2], const Unit& u, int wr, int wc, int fr, int fq) const {
        const int row0 = u.pm * BM + wr * 64 + fr, col0 = u.pn * BM + wc * 32 + 4 * fq;
#pragma unroll
        for (int ai = 0; ai < 2; ++ai)
#pragma unroll
            for (int m = 0; m < 4; ++m) { const size_t off = (size_t)(row0 + ai * HALF + m * 16) * 2048 + col0;
#pragma unroll
                for (int bj = 0; bj < 2; ++bj)
#pragma unroll
                    for (int n = 0; n < 2; ++n) *(f32x4*)(out + off + bj * HALF + n * 16) = acc[ai][bj][m][n] * sc; }
    }
};
struct MoeOrder {
    int nM, nN, nwg, G, c, wgm; const PG8_LAS int* tile_e;
    __device__ void init(int nM_, int N, int G_, int c_, const PG8_LAS int* te, int wgm_ = WGM) { nM = nM_; nN = N / BM; nwg = nM * nN; G = G_; c = c_; tile_e = te; wgm = wgm_; }
    __device__ bool next(int i, Unit& u) const {
        const long L = (long)i * G + c; if (L >= nwg) return false;
        int wgid = (int)L; { const int q = nwg / NXCD, r = nwg % NXCD, xcd = wgid % NXCD, off = wgid / NXCD; wgid = (xcd < r ? xcd * (q + 1) : r * (q + 1) + (xcd - r) * q) + off; }
        const int nig = wgm * nN, gid = wgid / nig, fm = gid * wgm, gsz = (nM - fm) < wgm ? (nM - fm) : wgm;
        u.pm = fm + ((wgid % nig) % gsz); u.pn = (wgid % nig) / gsz; u.be = __builtin_amdgcn_readfirstlane(tile_e[u.pm]); u.idx = i; u.koff = 0u; return true;
    }
    __device__ __forceinline__ void a_ready(const Unit&) const {}
    __device__ __forceinline__ void done(const Unit&) const {}
};

struct MoeSplitOrder {
    int nF, nR, S, G, c; unsigned slice_bytes; const PG8_LAS int* tile_e;
    __device__ bool next(int i, Unit& u) const {
        const int L = i * G + c; if (L >= nR * 8 * S) return false;
        const int t = L >> 3, ks = t / nR; u.pn = L & 7; u.pm = nF + (t - ks * nR); u.be = __builtin_amdgcn_readfirstlane(tile_e[u.pm]); u.idx = ks; u.koff = (unsigned)ks * slice_bytes; return true;
    }
    __device__ __forceinline__ void a_ready(const Unit&) const {}
    __device__ __forceinline__ void done(const Unit&) const {}
};
struct EpiF32P {
    static constexpr bool PERM = false, AFTER_DRAIN = false, HAS_MID = false;
    float* out; int nF, nR; float sc;
    __device__ __forceinline__ void operator()(const f32x4 (&acc)[2][2][4][2], const Unit& u, int wr, int wc, int fr, int fq) const {
        const int row0 = (u.idx * nR + (u.pm - nF)) * BM + wr * 64 + fr, col0 = u.pn * BM + wc * 32 + 4 * fq;
#pragma unroll
        for (int ai = 0; ai < 2; ++ai)
#pragma unroll
            for (int m = 0; m < 4; ++m) { const size_t off = (size_t)(row0 + ai * HALF + m * 16) * 2048 + col0;
#pragma unroll
                for (int bj = 0; bj < 2; ++bj)
#pragma unroll
                    for (int n = 0; n < 2; ++n) *(f32x4*)(out + off + bj * HALF + n * 16) = acc[ai][bj][m][n] * sc; }
    }
};
template <class Epi, class Sched, bool ALIGN_EPI = false, bool SP2 = false, bool FP8 = false>
__device__ __forceinline__ void gemm_phase(PG8_LAS unsigned char* lds, const Gemm g, const Sched& S, const Epi& E) {
    int tid_ = threadIdx.x; asm volatile("" : "+v"(tid_));
    const int tid = tid_, wid = __builtin_amdgcn_readfirstlane(tid >> 6), lane = tid & 63, wr = wid >> 2, wc = wid & 3, fr = lane & 15, fq = lane >> 4;
    const int K = g.K, nt = g.nt ? g.nt : K / BK;
    unsigned voffA[2], voffB[2];
#pragma unroll
    for (int i = 0; i < 2; ++i) { int R, C; stage_rc(tid * 16 + i * 8192, R, C); const int Rb = Epi::PERM ? ((R & ~31) + perm32(R & 31)) : R;
        voffA[i] = (unsigned)(R * K + C) * 2u; voffB[i] = (unsigned)(Rb * K + C) * 2u; }
    const size_t kstep = (size_t)(BK * 2);
    const size_t hstep = (size_t)HALF * K * 2;
    const size_t tstep = 2 * hstep;
    const unsigned ldsw = (unsigned)wid * 1024u;
    const int aoff = lds_byte(wr * 64 + fr, fq * 8), boff = lds_byte(wc * 32 + fr, fq * 8);
#define PG8_SA(b, h) (((b) * 2 + (h)) * HTB)
#define PG8_SB(b, h) ((4 + (b) * 2 + (h)) * HTB)
#define PG8_STAGE(bufoff, gbase, voff) do { _Pragma("unroll") for (int _i = 0; _i < 2; ++_i) \
        __builtin_amdgcn_global_load_lds((const unsigned*)((const char*)(gbase) + (voff)[_i]), (PG8_LAS unsigned*)(lds + (bufoff) + ldsw + _i * 8192), 16, 0, 0); } while (0)
#define PG8_LDA(dst, b, h) do { _Pragma("unroll") for (int m = 0; m < 4; ++m) _Pragma("unroll") for (int k = 0; k < 2; ++k) dst[m][k] = *(const PG8_LAS bf16x8*)(lds + PG8_SA(b, h) + aoff + m * 2048 + k * 1024); } while (0)
#define PG8_LDB(dst, b, h) do { _Pragma("unroll") for (int n = 0; n < 2; ++n) _Pragma("unroll") for (int k = 0; k < 2; ++k) dst[n][k] = *(const PG8_LAS bf16x8*)(lds + PG8_SB(b, h) + boff + n * 2048 + k * 1024); } while (0)
#define PG8_MMA(ai, bj, At, Bt) do { __builtin_amdgcn_s_setprio(1); _Pragma("unroll") for (int m = 0; m < 4; ++m) _Pragma("unroll") for (int n = 0; n < 2; ++n) { \
        if constexpr (FP8) acc[ai][bj][m][n] = mfma_fp8_128(Bt[n][0], Bt[n][1], At[m][0], At[m][1], acc[ai][bj][m][n]); \
        else { _Pragma("unroll") for (int k = 0; k < 2; ++k) acc[ai][bj][m][n] = __builtin_amdgcn_mfma_f32_16x16x32_bf16(Bt[n][k], At[m][k], acc[ai][bj][m][n], 0, 0, 0); } } \
        __builtin_amdgcn_s_setprio(0); } while (0)
#define PG8_WAIT_V(n) asm volatile("s_waitcnt vmcnt(" #n ")" ::: "memory")
#define PG8_WAIT_L(n) asm volatile("s_waitcnt lgkmcnt(" #n ")" ::: "memory")
#define PG8_BAR __builtin_amdgcn_s_barrier()
#define PG8_SCHED __builtin_amdgcn_sched_barrier(0)
    Unit cur, nxt; int ui = 0;
    if (!S.next(0, cur)) return;
    f32x4 acc[2][2][4][2];
#pragma unroll
    for (int a = 0; a < 2; ++a)
#pragma unroll
        for (int b = 0; b < 2; ++b)
#pragma unroll
            for (int m = 0; m < 4; ++m)
#pragma unroll
                for (int n = 0; n < 2; ++n) acc[a][b][m][n] = (f32x4){0.f, 0.f, 0.f, 0.f};
    bf16x8 At[4][2], B0[2][2], B1[2][2];
    const char* cA = (const char*)g.A + (size_t)cur.pm * tstep + cur.koff; const char* cB = (const char*)g.Bt + (size_t)cur.be * g.bstride + (size_t)cur.pn * tstep + cur.koff;
    S.a_ready(cur);
    if constexpr (SP2) {
        PG8_STAGE(PG8_SB(0, 0), cB, voffB); PG8_STAGE(PG8_SB(0, 1), cB + hstep, voffB); PG8_STAGE(PG8_SA(0, 0), cA, voffA); PG8_STAGE(PG8_SA(0, 1), cA + hstep, voffA);
        if (wr == 1) PG8_BAR;
        PG8_WAIT_V(2); PG8_BAR;
        PG8_STAGE(PG8_SB(1, 0), cB + kstep, voffB); PG8_STAGE(PG8_SA(1, 0), cA + kstep, voffA); PG8_STAGE(PG8_SB(1, 1), cB + hstep + kstep, voffB);
        PG8_WAIT_V(6); PG8_BAR;
    } else {
        PG8_STAGE(PG8_SB(0, 0), cB, voffB); PG8_STAGE(PG8_SA(0, 0), cA, voffA); PG8_STAGE(PG8_SB(0, 1), cB + hstep, voffB); PG8_STAGE(PG8_SA(0, 1), cA + hstep, voffA);
        if (wr == 1) PG8_BAR;
        PG8_WAIT_V(4); PG8_BAR;
        PG8_STAGE(PG8_SB(1, 0), cB + kstep, voffB); PG8_STAGE(PG8_SA(1, 0), cA + kstep, voffA); PG8_STAGE(PG8_SB(1, 1), cB + hstep + kstep, voffB);
        PG8_WAIT_V(6); PG8_BAR;
    }
    for (;;) {
        const bool has_next = S.next(ui + 1, nxt);
        const char* nA = has_next ? (const char*)g.A + (size_t)nxt.pm * tstep + nxt.koff : cA; const char* nB = has_next ? (const char*)g.Bt + (size_t)nxt.be * g.bstride + (size_t)nxt.pn * tstep + nxt.koff : cB;
        for (int t = 0; t < nt; t += 2) {
            if constexpr (Epi::HAS_MID) { if (t == nt / 2) E.mid(acc, cur, wr, wc, fr, fq); }
            const bool last = (t == nt - 2);
            const char* a1 = cA + (size_t)(t + 1) * kstep;
            const char* a2 = last ? nA : cA + (size_t)(t + 2) * kstep; const char* b2 = last ? nB : cB + (size_t)(t + 2) * kstep;
            const char* a3 = a2 + kstep; const char* b3 = b2 + kstep;
            if (last && has_next) S.a_ready(nxt);
            if constexpr (SP2) {
            PG8_LDB(B0, 0, 0); PG8_LDB(B1, 0, 1); PG8_SCHED; PG8_LDA(At, 0, 0); PG8_STAGE(PG8_SA(1, 1), a1 + hstep, voffA);
            PG8_WAIT_V(8); PG8_WAIT_L(0); PG8_BAR; PG8_MMA(0, 0, At, B0); PG8_MMA(0, 1, At, B1); PG8_BAR; PG8_SCHED;
            PG8_LDA(At, 0, 1); PG8_STAGE(PG8_SB(0, 0), b2, voffB); PG8_STAGE(PG8_SB(0, 1), b2 + hstep, voffB); PG8_STAGE(PG8_SA(0, 0), a2, voffA);
            PG8_WAIT_V(8); PG8_WAIT_L(0); PG8_BAR; PG8_MMA(1, 0, At, B0); PG8_MMA(1, 1, At, B1); PG8_BAR; PG8_SCHED;
            PG8_LDB(B0, 1, 0); PG8_LDB(B1, 1, 1); PG8_SCHED; PG8_LDA(At, 1, 0); PG8_STAGE(PG8_SA(0, 1), a2 + hstep, voffA);
            PG8_WAIT_V(8); PG8_WAIT_L(0); PG8_BAR; PG8_MMA(0, 0, At, B0); PG8_MMA(0, 1, At, B1); PG8_BAR; PG8_SCHED;
            PG8_LDA(At, 1, 1); PG8_STAGE(PG8_SB(1, 0), b3, voffB); PG8_STAGE(PG8_SB(1, 1), b3 + hstep, voffB); PG8_STAGE(PG8_SA(1, 0), a3, voffA);
            PG8_WAIT_V(8); PG8_WAIT_L(0); PG8_BAR; PG8_MMA(1, 0, At, B0); PG8_MMA(1, 1, At, B1); PG8_BAR; PG8_SCHED;
            } else {
            PG8_LDB(B0, 0, 0); PG8_SCHED; PG8_LDA(At, 0, 0); PG8_STAGE(PG8_SA(1, 1), a1 + hstep, voffA);
            PG8_WAIT_L(8); PG8_BAR; PG8_WAIT_L(0); PG8_MMA(0, 0, At, B0); PG8_BAR; PG8_SCHED;
            PG8_LDB(B1, 0, 1); PG8_STAGE(PG8_SB(0, 0), b2, voffB);
            PG8_BAR; PG8_WAIT_L(0); PG8_MMA(0, 1, At, B1); PG8_BAR;
            PG8_LDA(At, 0, 1); PG8_STAGE(PG8_SA(0, 0), a2, voffA);
            PG8_BAR; PG8_WAIT_L(0); PG8_MMA(1, 0, At, B0); PG8_BAR; PG8_SCHED;
            PG8_STAGE(PG8_SB(0, 1), b2 + hstep, voffB);
            PG8_WAIT_V(6); PG8_BAR; PG8_MMA(1, 1, At, B1); PG8_BAR;
            PG8_LDB(B0, 1, 0); PG8_SCHED; PG8_LDA(At, 1, 0); PG8_STAGE(PG8_SA(0, 1), a2 + hstep, voffA);
            PG8_WAIT_L(8); PG8_BAR; PG8_WAIT_L(0); PG8_MMA(0, 0, At, B0); PG8_BAR; PG8_SCHED;
            PG8_LDB(B1, 1, 1); PG8_STAGE(PG8_SB(1, 0), b3, voffB);
            PG8_BAR; PG8_WAIT_L(0); PG8_MMA(0, 1, At, B1); PG8_BAR;
            PG8_LDA(At, 1, 1); PG8_STAGE(PG8_SA(1, 0), a3, voffA);
            PG8_BAR; PG8_WAIT_L(0); PG8_MMA(1, 0, At, B0); PG8_BAR; PG8_SCHED;
            PG8_STAGE(PG8_SB(1, 1), b3 + hstep, voffB);
            PG8_WAIT_V(6); PG8_BAR; PG8_MMA(1, 1, At, B1); PG8_BAR;
            }
        }
        if constexpr (ALIGN_EPI) { if (wr == 0) PG8_BAR; }
        if constexpr (FP8) {
            asm volatile("s_nop 15\n\ts_nop 15" : "+v"(acc[0][0][0][0]), "+v"(acc[0][0][0][1]), "+v"(acc[0][0][1][0]), "+v"(acc[0][0][1][1]), "+v"(acc[0][0][2][0]), "+v"(acc[0][0][2][1]), "+v"(acc[0][0][3][0]), "+v"(acc[0][0][3][1]));
            asm volatile("" : "+v"(acc[0][1][0][0]), "+v"(acc[0][1][0][1]), "+v"(acc[0][1][1][0]), "+v"(acc[0][1][1][1]), "+v"(acc[0][1][2][0]), "+v"(acc[0][1][2][1]), "+v"(acc[0][1][3][0]), "+v"(acc[0][1][3][1]));
            asm volatile("" : "+v"(acc[1][0][0][0]), "+v"(acc[1][0][0][1]), "+v"(acc[1][0][1][0]), "+v"(acc[1][0][1][1]), "+v"(acc[1][0][2][0]), "+v"(acc[1][0][2][1]), "+v"(acc[1][0][3][0]), "+v"(acc[1][0][3][1]));
            asm volatile("" : "+v"(acc[1][1][0][0]), "+v"(acc[1][1][0][1]), "+v"(acc[1][1][1][0]), "+v"(acc[1][1][1][1]), "+v"(acc[1][1][2][0]), "+v"(acc[1][1][2][1]), "+v"(acc[1][1][3][0]), "+v"(acc[1][1][3][1]));
        }
        if constexpr (!Epi::AFTER_DRAIN) { E(acc, cur, wr, wc, fr, fq); S.done(cur); }
        if (!has_next) break;
#pragma unroll
        for (int a = 0; a < 2; ++a)
#pragma unroll
            for (int b = 0; b < 2; ++b)
#pragma unroll
                for (int m = 0; m < 4; ++m)
#pragma unroll
                    for (int n = 0; n < 2; ++n) acc[a][b][m][n] = (f32x4){0.f, 0.f, 0.f, 0.f};
        cur = nxt; cA = nA; cB = nB; ++ui;
        if constexpr (ALIGN_EPI) { if (wr == 1) PG8_BAR; }
    }
    PG8_WAIT_V(0);
    if constexpr (!ALIGN_EPI) { if (wr == 0) PG8_BAR; }
    PG8_BAR;
    if constexpr (Epi::AFTER_DRAIN) { E.fused(acc, cur, wr, wc, fr, fq, lds, wid, lane); S.done(cur); }
#undef PG8_SA
#undef PG8_SB
#undef PG8_STAGE
#undef PG8_LDA
#undef PG8_LDB
#undef PG8_MMA
#undef PG8_WAIT_V
#undef PG8_WAIT_L
#undef PG8_BAR
#undef PG8_SCHED
}
}

namespace att {
typedef unsigned short bf16;
typedef short bf16x8 __attribute__((ext_vector_type(8)));
typedef short s16x4 __attribute__((ext_vector_type(4)));
typedef float f32x16 __attribute__((ext_vector_type(16)));
typedef float f32x4 __attribute__((ext_vector_type(4)));
typedef unsigned u32x4 __attribute__((ext_vector_type(4)));
typedef unsigned u32x2 __attribute__((ext_vector_type(2)));
constexpr int D = 128, NW = 8, QBLK = 32, KVBLK = 64, QB = NW * QBLK;
constexpr int PQ = 6144, PO = 2048;
constexpr int SHM_V = KVBLK * D * 2, SHM_K = KVBLK * D * 2;
constexpr int L_V = 0, L_K = 2 * SHM_V, L_WS = L_K + 2 * SHM_K, L_BIAS = L_WS + NW * 64 * 4, L_KM = L_BIAS + 512, L_Q = L_KM + 8192, L_FB = L_Q + NW * 8192, L_END = L_FB + 4096 * 4;
constexpr float SCALE = 0.08838834764831845f, THR = 8.f;
#define KSWZ(row, colB) ((row) * 256 + ((colB) ^ (((row) & 7) << 4)))
#define SBAR() __builtin_amdgcn_sched_barrier(0)
#ifndef ATT_QREG_FOX
#define ATT_QREG_FOX 1
#endif
#define QREG(MODE) ((MODE) == 1 && ATT_QREG_FOX)
#define AL __attribute__((address_space(3)))
__device__ __forceinline__ int v_st(int k, int c) { const int kk = (k & ~0xC) | ((k & 4) << 1) | ((k & 8) >> 1); return ((kk >> 3) * 4 + (c >> 5)) * 512 + ((kk & 7) * 32 + (c & 31)) * 2; }
__device__ __forceinline__ int v_rd_base(int lane) { return ((lane & 3) << 3) | (((lane >> 2) & 3) << 6) | (((lane >> 4) & 1) << 5) | (((lane >> 5) & 1) << 8); }
constexpr int v_rd_off(int d0, int ks, int half) { return d0 * 512 + ks * 4096 + half * 2048; }
__device__ __forceinline__ int crow(int r, int hi) { return (r & 3) + 8 * (r >> 2) + 4 * hi; }
__device__ __forceinline__ unsigned cvtpk(float lo, float hi) { unsigned r; asm volatile("v_cvt_pk_bf16_f32 %0, %1, %2" : "=v"(r) : "v"(lo), "v"(hi)); return r; }
__device__ __forceinline__ bf16x8 ld8(__amdgpu_buffer_rsrc_t rs, unsigned voff, unsigned soff) { const u32x4 w = __builtin_amdgcn_raw_buffer_load_b128(rs, (int)voff, (int)soff, 0); return __builtin_bit_cast(bf16x8, w); }
__device__ __forceinline__ void glds16(const void* gsrc, unsigned lds_dst) { unsigned keep;
    asm volatile("s_mov_b32 %0, m0\n\ts_mov_b32 m0, %2\n\ts_nop 0\n\tglobal_load_lds_dwordx4 %1, off\n\ts_mov_b32 m0, %0" : "=&s"(keep) : "v"(gsrc), "s"(lds_dst) : "memory"); }
__device__ __forceinline__ void mask_tile(f32x16& p0, f32x16& p1, int dq) {
    const float NEG = -__builtin_inff();
#pragma unroll
    for (int r = 0; r < 16; ++r) { const int c = (r & 3) + 8 * (r >> 2); if (dq - c < 0) p0[r] = NEG; if (dq - c - 32 < 0) p1[r] = NEG; }
}
__device__ __forceinline__ void partialSM(f32x16& p0, f32x16& p1, float& m_reg, float& mn, float& alpha) {
    float pmax = p0[0]; for (int r = 1; r < 16; ++r) pmax = fmaxf(pmax, p0[r]); for (int r = 0; r < 16; ++r) pmax = fmaxf(pmax, p1[r]);
    { auto rr = __builtin_amdgcn_permlane32_swap(__float_as_uint(pmax), __float_as_uint(pmax), false, false); pmax = fmaxf(__uint_as_float(rr[0]), __uint_as_float(rr[1])); }
    constexpr float C2 = 1.4426950408889634f * SCALE;
    if (__builtin_expect(__all((pmax - m_reg) * SCALE <= THR), 1)) { mn = m_reg; alpha = 1.f; }
    else { mn = fmaxf(m_reg, pmax); alpha = __builtin_amdgcn_exp2f((m_reg - mn) * C2); m_reg = mn; }
    const float mnL = -mn * C2;
    for (int r = 0; r < 16; ++r) p0[r] = fmaf(p0[r], C2, mnL); for (int r = 0; r < 16; ++r) p1[r] = fmaf(p1[r], C2, mnL);
    for (int r = 0; r < 16; ++r) p0[r] = __builtin_amdgcn_exp2f(p0[r]);
}
__device__ __forceinline__ void finishSM(f32x16& p0, f32x16& p1, float alpha, float& l_reg, bf16x8& pa0, bf16x8& pa1, bf16x8& pa2, bf16x8& pa3) {
    for (int r = 0; r < 16; ++r) p1[r] = __builtin_amdgcn_exp2f(p1[r]);
    float ps = 0; for (int r = 0; r < 16; ++r) ps += p0[r]; for (int r = 0; r < 16; ++r) ps += p1[r];
    { auto rr = __builtin_amdgcn_permlane32_swap(__float_as_uint(ps), __float_as_uint(ps), false, false); ps = __uint_as_float(rr[0]) + __uint_as_float(rr[1]); }
    l_reg = l_reg * alpha + ps;
#define PK4(P, B_, OUT) do { unsigned a0 = cvtpk(P[B_+0], P[B_+1]), a1 = cvtpk(P[B_+2], P[B_+3]);                          \
        unsigned b0 = cvtpk(P[B_+4], P[B_+5]), b1 = cvtpk(P[B_+6], P[B_+7]);                                             \
        auto r0 = __builtin_amdgcn_permlane32_swap(a0, b0, false, false); auto r1 = __builtin_amdgcn_permlane32_swap(a1, b1, false, false); \
        u32x4 w = {r0[0], r1[0], r0[1], r1[1]}; OUT = *reinterpret_cast<bf16x8*>(&w); } while (0)
    PK4(p0, 0, pa0); PK4(p0, 8, pa1); PK4(p1, 0, pa2); PK4(p1, 8, pa3);
#undef PK4
}
template <int KB, int MODE>
__device__ __forceinline__ void qkt(f32x16& p0, f32x16& p1, const AL char* lds, int r32, int hi, const AL char* qf, const bf16x8* qr, float rb, int k0) {
    if constexpr (MODE == 1) {
        const AL f32x4* f = (const AL f32x4*)(lds + L_FB + (k0 + 4 * hi) * 4);
        const f32x4 a0 = f[0], a1 = f[2], a2 = f[4], a3 = f[6], b0 = f[8], b1 = f[10], b2 = f[12], b3 = f[14];
        typedef float f32x8 __attribute__((ext_vector_type(8)));
        const f32x8 a01 = __builtin_shufflevector(a0, a1, 0, 1, 2, 3, 4, 5, 6, 7), a23 = __builtin_shufflevector(a2, a3, 0, 1, 2, 3, 4, 5, 6, 7);
        const f32x8 b01 = __builtin_shufflevector(b0, b1, 0, 1, 2, 3, 4, 5, 6, 7), b23 = __builtin_shufflevector(b2, b3, 0, 1, 2, 3, 4, 5, 6, 7);
        p0 = __builtin_shufflevector(a01, a23, 0, 1, 2, 3, 4, 5, 6, 7, 8, 9, 10, 11, 12, 13, 14, 15);
        p1 = __builtin_shufflevector(b01, b23, 0, 1, 2, 3, 4, 5, 6, 7, 8, 9, 10, 11, 12, 13, 14, 15); }
    else {
#pragma unroll
        for (int r = 0; r < 16; ++r) { p0[r] = rb; p1[r] = rb; } }
    const AL char* K_lds = lds + L_K; const AL char* kb[4];
#pragma unroll
    for (int dd = 0; dd < 4; ++dd) kb[dd] = K_lds + KB * SHM_K + KSWZ(r32, (dd * 16 + hi * 8) * 2);
#pragma unroll
    for (int d0 = 0; d0 < 8; ++d0) { const AL char* a = kb[d0 & 3] + (d0 >> 2) * 128;
        bf16x8 b0 = *(const AL bf16x8*)(a);
        bf16x8 b1 = *(const AL bf16x8*)(a + 32 * 256);
        const bf16x8 q = QREG(MODE) ? qr[d0] : *(const AL bf16x8*)(qf + d0 * 1024);
        p0 = __builtin_amdgcn_mfma_f32_32x32x16_bf16(b0, q, p0, 0, 0, 0);
        p1 = __builtin_amdgcn_mfma_f32_32x32x16_bf16(b1, q, p1, 0, 0, 0); }
}
template <int VB>
__device__ __forceinline__ void pv_tile(f32x16* o, int vb0, bf16x8 pa0, bf16x8 pa1, bf16x8 pa2, bf16x8 pa3) {
#define TRRD(dst, off) asm volatile("ds_read_b64_tr_b16 %0, %1 offset:%2" : "=&v"(dst) : "v"(vb0), "i"(off) : "memory")
#define PV_D0(d0) do { s16x4 l0, l1, l2, l3, h0, h1, h2, h3; constexpr int b_ = VB * SHM_V + v_rd_off(d0, 0, 0);   \
        TRRD(l0, b_); TRRD(h0, b_ + 2048); TRRD(l1, b_ + 4096); TRRD(h1, b_ + 6144); TRRD(l2, b_ + 8192); TRRD(h2, b_ + 10240); TRRD(l3, b_ + 12288); TRRD(h3, b_ + 14336); \
        asm volatile("s_waitcnt lgkmcnt(0)" ::: "memory"); SBAR();                                                    \
        o[d0] = __builtin_amdgcn_mfma_f32_32x32x16_bf16(pa0, (bf16x8){l0[0], l0[1], l0[2], l0[3], h0[0], h0[1], h0[2], h0[3]}, o[d0], 0, 0, 0);   \
        o[d0] = __builtin_amdgcn_mfma_f32_32x32x16_bf16(pa1, (bf16x8){l1[0], l1[1], l1[2], l1[3], h1[0], h1[1], h1[2], h1[3]}, o[d0], 0, 0, 0);   \
        o[d0] = __builtin_amdgcn_mfma_f32_32x32x16_bf16(pa2, (bf16x8){l2[0], l2[1], l2[2], l2[3], h2[0], h2[1], h2[2], h2[3]}, o[d0], 0, 0, 0);   \
        o[d0] = __builtin_amdgcn_mfma_f32_32x32x16_bf16(pa3, (bf16x8){l3[0], l3[1], l3[2], l3[3], h3[0], h3[1], h3[2], h3[3]}, o[d0], 0, 0, 0); } while (0)
    PV_D0(0); PV_D0(1); PV_D0(2); PV_D0(3);
#undef PV_D0
#undef TRRD
}
struct Ref { unsigned Q, K, V, O; int qb; int row0, head16; };
struct Seam { bf16x8 st_v0, st_v1, st_k0, st_k1; };
#define VMW() asm volatile("s_waitcnt vmcnt(0)" ::: "memory")
#define VMWN(n) asm volatile("s_waitcnt vmcnt(%0)" :: "i"(n) : "memory")
#define SLOAD_H(R, k0) do { const unsigned kt_ = (R).K + (unsigned)(k0) * (2u * PQ), vt_ = (R).V + (unsigned)(k0) * (2u * PQ);                                                                \
                            S.st_v0 = ld8(rsq, vo0, vt_); S.st_v1 = ld8(rsq, vo1, vt_); S.st_k0 = ld8(rsq, vo0, kt_); S.st_k1 = ld8(rsq, vo1, kt_); } while (0)
#define SWRITE_HK(bf) do { *(AL bf16x8*)(K_lds + (bf) * SHM_K + kws) = S.st_k0; *(AL bf16x8*)(K_lds + (bf) * SHM_K + kws + 32 * 256) = S.st_k1; } while (0)
#define SWRITE_HV(bf) do { *(AL bf16x8*)(V_lds + (bf) * SHM_V + vst0) = S.st_v0; *(AL bf16x8*)(V_lds + (bf) * SHM_V + vst1) = S.st_v1; } while (0)
#define SWRITE_H(bf) do { SWRITE_HV(bf); SWRITE_HK(bf); } while (0)
#define ATT_IDS int tid_ = threadIdx.x; asm volatile("" : "+v"(tid_)); const int tid = tid_, wid = __builtin_amdgcn_readfirstlane(tid >> 6), lane = tid & 63, r32 = lane & 31, hi = lane >> 5;   \
    const int sr = tid >> 4, sc = (tid & 15) * 8, kws = KSWZ(sr, sc * 2);                                                                           \
    const unsigned vo0 = 2u * (unsigned)(sr * PQ + sc), vo1 = vo0 + 64u * PQ, voq = 2u * (unsigned)((wid * QBLK + r32) * PQ + hi * 8); (void)vo0; (void)vo1; (void)voq;     \
    AL char* V_lds = lds + L_V; AL char* K_lds = lds + L_K; (void)V_lds; (void)hi; (void)r32;                                                \
    const AL char* qf = lds + L_Q + wid * 8192 + lane * 16; const unsigned qdma = (unsigned)(uintptr_t)(lds + L_Q) + (unsigned)wid * 8192u; (void)qf; (void)qdma
template <int MODE>
__device__ __forceinline__ void prime(const Ref& cur, AL char* lds, Seam& S, __amdgpu_buffer_rsrc_t rsq, const char* qkvb) {
    ATT_IDS;
#pragma unroll
    for (int d0 = 0; d0 < 8; ++d0) glds16(qkvb + cur.Q + voq + d0 * 32, (unsigned)__builtin_amdgcn_readfirstlane(qdma + d0 * 1024));
    SLOAD_H(cur, 0); VMW(); SWRITE_HK(0);
    __syncthreads();
}
template <int MODE>
__device__ __forceinline__ void block(const Ref& cur, const Ref& nxt, AL char* lds, Seam& S, unsigned selmask, __amdgpu_buffer_rsrc_t rsq, __amdgpu_buffer_rsrc_t rso, const char* qkvb, float* ssq) {
    ATT_IDS;
    const int NT = 4 * (cur.qb + 1);
    const int qlo = cur.qb * QB + wid * QBLK, qm = qlo + r32 - 4 * hi;
    AL float* ws = (AL float*)(lds + L_WS) + wid * 64; AL float* li_l = ws; AL float* al_l = ws + 32;
    float m_reg = -1e30f, l_reg = 0; f32x16 o[4] = {};
    const int vst0 = v_st(sr, sc), vst1 = v_st(32 + sr, sc);
    const int vb0 = (int)(unsigned)(uintptr_t)V_lds + v_rd_base(lane);
    const float NEGI = -__builtin_inff();
#define RESC(a) do { if (__any((a) < 1.f)) { if (hi == 0) al_l[r32] = (a); asm volatile("s_waitcnt lgkmcnt(0)" ::: "memory");              \
                     for (int d_ = 0; d_ < 4; ++d_) for (int r = 0; r < 16; ++r) o[d_][r] *= al_l[crow(r, hi)]; } } while (0)
#define KBASE(t) ((t) * KVBLK)
#define RB(t) ((MODE == 0) ? (((selmask >> ((t) >> 2)) & 1u) ? 0.f : NEGI) : 0.f)
#define MASKT(P0_, P1_, t) do { const int kb_ = KBASE(t); if (kb_ + KVBLK - 1 > qlo) mask_tile(P0_, P1_, qm - kb_); } while (0)
#define SEAM_K0() do { VMWN(8); SWRITE_HK(0); SBAR(); } while (0)
    f32x16 pA0, pA1, pB0, pB1; float mnA, mnB, alA, alB; bf16x8 pa0, pa1, pa2, pa3;
    bf16x8 qr[8];
    if constexpr (QREG(MODE)) {
#pragma unroll
        for (int d0 = 0; d0 < 8; ++d0) qr[d0] = *(const AL bf16x8*)(qf + d0 * 1024); }
    SWRITE_HV(0); SBAR();
    SLOAD_H(cur, KBASE(1));
    SBAR(); qkt<0, MODE>(pA0, pA1, lds, r32, hi, qf, qr, RB(0), 0);
    MASKT(pA0, pA1, 0); partialSM(pA0, pA1, m_reg, mnA, alA);
    VMW(); SWRITE_H(1);
    __syncthreads();
#define HALF_STEP(PX0, PX1, mnX, alX, PY0, PY1, alY, t, KB, VB, SB) do {                                                      \
        SBAR(); qkt<KB, MODE>(PX0, PX1, lds, r32, hi, qf, qr, RB(t), KBASE(t));                                                          \
        finishSM(PY0, PY1, alY, l_reg, pa0, pa1, pa2, pa3); SBAR();                                                           \
        if ((t) + 1 < NT) { SLOAD_H(cur, KBASE((t) + 1)); SBAR(); }                                                           \
        pv_tile<VB>(o, vb0, pa0, pa1, pa2, pa3); MASKT(PX0, PX1, (t)); partialSM(PX0, PX1, m_reg, mnX, alX);                  \
        __syncthreads();                                                                                                      \
        if ((t) + 1 < NT) { VMW(); SWRITE_H(SB); }                                                                            \
        RESC(alX); __syncthreads(); } while (0)
    for (int t = 1; t + 1 < NT; t += 2) {
        HALF_STEP(pB0, pB1, mnB, alB, pA0, pA1, alA, t, 1, 0, 0);
        HALF_STEP(pA0, pA1, mnA, alA, pB0, pB1, alB, t + 1, 0, 1, 1);
    }
    SBAR(); qkt<1, MODE>(pB0, pB1, lds, r32, hi, qf, qr, RB(NT - 1), KBASE(NT - 1)); asm volatile("s_waitcnt lgkmcnt(0)" ::: "memory"); SBAR();
    SLOAD_H(nxt, 0); SBAR();
#pragma unroll
    for (int d0 = 0; d0 < 8; ++d0) glds16(qkvb + nxt.Q + voq + d0 * 32, (unsigned)__builtin_amdgcn_readfirstlane(qdma + d0 * 1024));
    SBAR();
    finishSM(pA0, pA1, alA, l_reg, pa0, pa1, pa2, pa3); SBAR();
    pv_tile<0>(o, vb0, pa0, pa1, pa2, pa3);
    MASKT(pB0, pB1, NT - 1); partialSM(pB0, pB1, m_reg, mnB, alB); __syncthreads(); RESC(alB);
    finishSM(pB0, pB1, alB, l_reg, pa0, pa1, pa2, pa3); SBAR(); pv_tile<1>(o, vb0, pa0, pa1, pa2, pa3);
    SBAR(); SEAM_K0();
    if (hi == 0) li_l[r32] = l_reg; asm volatile("s_waitcnt lgkmcnt(0)" ::: "memory");
    float rli[16];
#pragma unroll
    for (int r = 0; r < 16; ++r) rli[r] = __builtin_amdgcn_rcpf(li_l[crow(r, hi)]);
    const unsigned vofo = 2u * (unsigned)(hi * 4 * PO + r32);
    float sq[16];
#pragma unroll
    for (int r = 0; r < 16; ++r) { const unsigned Or = cur.O + (unsigned)(wid * QBLK + (r & 3) + 8 * (r >> 2)) * (2u * PO);
        float s2 = 0.f;
#pragma unroll
        for (int d0 = 0; d0 < 4; ++d0) { const float v = o[d0][r] * rli[r]; s2 += v * v;
            const float vn = __shfl_xor(v, 1);
            if ((r32 & 1) == 0) __builtin_amdgcn_raw_buffer_store_b32(cvtpk(v, vn), rso, (int)(vofo + d0 * 64), (int)Or, 0); }
        sq[r] = s2; }
    {
        float a8[8], a4[4], a2[2], a1;
        const bool b4 = (r32 & 16) != 0, b3 = (r32 & 8) != 0, b2 = (r32 & 4) != 0, b1 = (r32 & 2) != 0;
#pragma unroll
        for (int i = 0; i < 8; ++i) { const float send = b4 ? sq[i] : sq[i + 8], keep = b4 ? sq[i + 8] : sq[i]; a8[i] = keep + __shfl_xor(send, 16); }
#pragma unroll
        for (int i = 0; i < 4; ++i) { const float send = b3 ? a8[i] : a8[i + 4], keep = b3 ? a8[i + 4] : a8[i]; a4[i] = keep + __shfl_xor(send, 8); }
#pragma unroll
        for (int i = 0; i < 2; ++i) { const float send = b2 ? a4[i] : a4[i + 2], keep = b2 ? a4[i + 2] : a4[i]; a2[i] = keep + __shfl_xor(send, 4); }
        { const float send = b1 ? a2[0] : a2[1], keep = b1 ? a2[1] : a2[0]; a1 = keep + __shfl_xor(send, 2); }
        a1 += __shfl_xor(a1, 1);
        const int r = r32 >> 1, rowl = wid * QBLK + (r & 3) + 8 * (r >> 2) + 4 * hi;
        if ((r32 & 1) == 0) ssq[((size_t)cur.row0 + rowl) * 16 + cur.head16] = a1;
    }
    __syncthreads();
#undef RESC
#undef KBASE
#undef RB
#undef MASKT
#undef SEAM_K0
#undef HALF_STEP
}
__device__ __forceinline__ unsigned moba_select(const AL char* qf, const AL char* lds, int qb, int r32, int hi) {
    f32x16 g = {};
    const AL char* kb[4];
#pragma unroll
    for (int dd = 0; dd < 4; ++dd) kb[dd] = lds + L_KM + KSWZ(r32, (dd * 16 + hi * 8) * 2);
#pragma unroll
    for (int d0 = 0; d0 < 8; ++d0) { const bf16x8 b0 = *(const AL bf16x8*)(kb[d0 & 3] + (d0 >> 2) * 128); g = __builtin_amdgcn_mfma_f32_32x32x16_bf16(b0, *(const AL bf16x8*)(qf + d0 * 1024), g, 0, 0, 0); }
    float gv[16];
#pragma unroll
    for (int i = 0; i < 8; ++i) { auto rr = __builtin_amdgcn_permlane32_swap(__float_as_uint(g[i]), __float_as_uint(g[i]), false, false);
        const int bl = (i & 3) + 8 * (i >> 2); gv[bl] = __uint_as_float(rr[0]); gv[bl + 4] = __uint_as_float(rr[1]); }
    unsigned mask = 0u;
#pragma unroll
    for (int p = 0; p < 3; ++p) { float best = -__builtin_inff(); int bi = -1;
#pragma unroll
        for (int n = 0; n < 16; ++n) { const bool c = (n < qb) && (((mask >> n) & 1u) == 0u) && (gv[n] > best); best = c ? gv[n] : best; bi = c ? n : bi; }
        if (bi >= 0) mask |= 1u << bi; }
    return mask | (1u << qb);
}
struct Tensors { const bf16* QKV; bf16* OB; const float* LOGF; const float* KSUM; float* SSQ; };
template <int MODE>
__device__ __forceinline__ Ref mkref(const Tensors& T, int bh, int qb) {
    const int b = bh >> 3, h = bh & 7; Ref r;
    const unsigned row0 = (unsigned)b * 4096u;
    constexpr unsigned QC = MODE == 0 ? 0 : 3072, KC = MODE == 0 ? 1024 : 4096, VC = MODE == 0 ? 2048 : 5120, OC = MODE == 0 ? 0 : 1024;
    r.Q = 2u * ((row0 + (unsigned)qb * QB) * PQ + QC + h * D); r.K = 2u * (row0 * PQ + KC + h * D); r.V = 2u * (row0 * PQ + VC + h * D);
    r.O = 2u * ((row0 + (unsigned)qb * QB) * PO + OC + h * D); r.qb = qb; r.row0 = (int)(row0 + (unsigned)qb * QB); r.head16 = (MODE == 0 ? 0 : 8) + h; return r;
}
template <int MODE>
__device__ __forceinline__ void attn_phase(AL char* lds, const Tensors& T, int vcu, int G) {
    int tid_ = threadIdx.x; asm volatile("" : "+v"(tid_));
    const int tid = tid_, lane = tid & 63, r32 = lane & 31, hi = lane >> 5, wid = __builtin_amdgcn_readfirstlane(tid >> 6);
    const AL char* qf = lds + L_Q + wid * 8192 + lane * 16;
    const __amdgpu_buffer_rsrc_t rsq = __builtin_amdgcn_make_buffer_rsrc((void*)T.QKV, (short)0, (int)(16384u * PQ * 2u), 0x00020000);
    const __amdgpu_buffer_rsrc_t rso = __builtin_amdgcn_make_buffer_rsrc((void*)T.OB, (short)0, (int)(16384u * PO * 2u), 0x00020000);
    const char* qkvb = (const char*)T.QKV;
    for (int item = vcu; item < 256; item += G) {
        const int bh = item >> 3, s = item & 7;
        if constexpr (MODE == 0) {
            const int row = tid >> 5, c4 = (tid & 31) * 4;
            const f32x4 v = *(const f32x4*)((const char*)(T.KSUM + (size_t)bh * 2048) + 4u * (unsigned)(row * 128 + c4)) * (1.0f / 256.0f);
            u32x2 w; w.x = cvtpk(v[0], v[1]); w.y = cvtpk(v[2], v[3]);
            *(AL u32x2*)(lds + L_KM + KSWZ(row, c4 * 2)) = w;
        }
        if constexpr (MODE == 1) {
            AL float* fbL = (AL float*)(lds + L_FB); AL float* wsum = (AL float*)(lds + L_BIAS);
            const float* lf = T.LOGF + (size_t)bh * 4096 + wid * 512 + lane * 8;
            f32x4 a = *(const f32x4*)lf, b = *(const f32x4*)(lf + 4);
            a[1] += a[0]; a[2] += a[1]; a[3] += a[2]; b[0] += a[3]; b[1] += b[0]; b[2] += b[1]; b[3] += b[2];
            float inc = b[3];
#pragma unroll
            for (int o = 1; o < 64; o <<= 1) { const float t = __shfl_up(inc, o); if (lane >= o) inc += t; }
            if (lane == 63) wsum[wid] = inc;
            __syncthreads();
            float base = inc - b[3];
#pragma unroll
            for (int w = 0; w < 7; ++w) if (w < wid) base += wsum[w];
            constexpr float NIS = -11.313708498984761f;
            *(AL f32x4*)(fbL + wid * 512 + lane * 8) = (a + base) * NIS; *(AL f32x4*)(fbL + wid * 512 + lane * 8 + 4) = (b + base) * NIS;
        }
        Ref cur = mkref<MODE>(T, bh, s), nxt = mkref<MODE>(T, bh, 15 - s);
        Seam S; prime<MODE>(cur, lds, S, rsq, qkvb);
        for (int i = 0; i < 2; ++i) {
            unsigned selmask = 0u;
            VMW();
            if constexpr (MODE == 0) selmask = moba_select(qf, lds, cur.qb, r32, hi);
            block<MODE>(cur, nxt, lds, S, selmask, rsq, rso, qkvb, T.SSQ);
            cur = nxt;
        }
    }
}
#undef VMW
#undef VMWN
#undef SLOAD_H
#undef SWRITE_HK
#undef SWRITE_HV
#undef SWRITE_H
#undef ATT_IDS
#undef KSWZ
#undef SBAR
#undef AL
}

constexpr int NWAVES = 8;
constexpr int DM = 2048, NB = 4, SEQ = 4096, NTOK = NB * SEQ, NLAYER = 2, NHG = 8, HD = 128;
constexpr int INW = 6152, NQKV = 6144, DFF = 7168, NEXP = 8, NGU = 2 * DFF;
constexpr int MOE_ROWS = 34816;
constexpr float EPS = 1e-6f;
constexpr size_t MiB = 1u << 20;
constexpr size_t WS_CTL = 0, CTL_ZERO_BYTES = 1 * MiB;
constexpr size_t WS_MOD = 1 * MiB;
constexpr size_t WS_ROPE = 2 * MiB;
constexpr size_t WS_WFZ = 4 * MiB;
constexpr size_t WS_LOGF = 5 * MiB;
constexpr size_t WS_FBIAS = 6 * MiB;
constexpr size_t WS_KMEAN = 7 * MiB;
constexpr size_t WS_ROUTE = 8 * MiB;
constexpr size_t WS_PART = 9 * MiB;
constexpr size_t WS_WIN = 21 * MiB;
constexpr size_t WS_WO = 69 * MiB;
constexpr size_t WS_WGU = 85 * MiB;
constexpr size_t WS_WD = 589 * MiB;
constexpr size_t WS_WGU8 = WS_WGU + 56 * MiB, WS_WD8 = WS_WD + 28 * MiB;
constexpr size_t WS_XB = WS_WGU + 288 * MiB;
constexpr size_t WS_H = 841 * MiB;
constexpr size_t WS_A = 905 * MiB;
constexpr size_t WS_QKV = WS_A, WS_O = WS_A + 192 * MiB, WS_ACT = WS_A + 256 * MiB;
constexpr size_t WS_HS = WS_A, WS_ACTM = WS_A + 136 * MiB, WS_YS = WS_A + 612 * MiB;
constexpr size_t WS_YP = WS_YS + 136 * MiB;
constexpr size_t WS_END = WS_A + 884 * MiB;
static_assert((size_t)MOE_ROWS * DM * 2 <= 136 * MiB && (size_t)MOE_ROWS * DFF * 2 <= 476 * MiB && (size_t)MOE_ROWS * DM * 4 <= 272 * MiB, "MoE overlay");
static_assert((size_t)NTOK * NQKV * 2 <= 192 * MiB && (size_t)NTOK * DFF * 2 <= 224 * MiB, "layer overlay");
constexpr int CW_BAR = 4096;
constexpr size_t WS_TAB = 512 * 1024;
constexpr int RING_OFF = 0, RING_BYTES = 159744;
constexpr int LDSCTL_OFF = RING_BYTES, MISC_OFF = LDSCTL_OFF + 320;
constexpr int TILE_E_OFF = LDSCTL_OFF + 1024;
constexpr int RS_OFF = 131072, RS_UNITS = 4;
constexpr int LDS_BYTES = 163840;
static_assert(att::L_END <= RING_BYTES && TILE_E_OFF + 1024 <= LDS_BYTES && pg8::STAGE_BYTES <= RING_BYTES, "LDS map");

#define GAS __attribute__((address_space(1)))
#define LAS __attribute__((address_space(3)))
typedef unsigned short bf16;
typedef unsigned v4u __attribute__((ext_vector_type(4)));
typedef unsigned v2u __attribute__((ext_vector_type(2)));
typedef float f32x4 __attribute__((ext_vector_type(4)));
typedef GAS unsigned gu32;
#define RLX_AGENT __ATOMIC_RELAXED, __HIP_MEMORY_SCOPE_AGENT
#define LDS_WAIT() asm volatile("s_waitcnt lgkmcnt(0)" ::: "memory")
__device__ __forceinline__ unsigned f2bf(float f) { unsigned u = __builtin_bit_cast(unsigned, f); return (u + 0x7fffu + ((u >> 16) & 1u)) >> 16; }
__device__ __forceinline__ unsigned pk2(float lo, float hi) { return f2bf(lo) | (f2bf(hi) << 16); }
__device__ __forceinline__ float bf2f(unsigned short b) { return __builtin_bit_cast(float, (unsigned)b << 16); }
__device__ __forceinline__ float wave_sum(float v) {
#pragma unroll
    for (int o = 1; o < 64; o <<= 1) v += __shfl_xor(v, o);
    return v;
}
#define XB_TMO      128
#define XB_XCNT(j)  (256  + 64 * (j))
#define XB_XSUB(j)  (1280 + 64 * (j))
#define XB_XGEN(j)  (2304 + 64 * (j))
#define XB_TOP      3328
#define XB_TOPGEN   3392
#define XCD_BAR_WORDS 3456
#define XB_SPIN_CAP (1u << 18)

__device__ __forceinline__ unsigned xb_ld(unsigned* p)              { return __hip_atomic_load((GAS unsigned*)p, __ATOMIC_RELAXED, __HIP_MEMORY_SCOPE_AGENT); }
__device__ __forceinline__ unsigned xb_add(unsigned* p, unsigned v) { return __hip_atomic_fetch_add((GAS unsigned*)p, v, __ATOMIC_RELAXED, __HIP_MEMORY_SCOPE_AGENT); }
__device__ __forceinline__ unsigned xb_xcc_id() { return (unsigned)__builtin_amdgcn_s_getreg((3 << 11) | 20) & 0xFu; }
#define XB_SPIN(cond, bar) do { unsigned _sp = 0; while (cond) { __builtin_amdgcn_s_sleep(1); \
    if ((++_sp & 255u) == 0u) { if (xb_ld(&(bar)[XB_TMO])) break; if (_sp > XB_SPIN_CAP) { (void)xb_add(&(bar)[XB_TMO], 1u); break; } } } } while (0)

struct XcdBarrier {
    unsigned* bar; unsigned x;
    volatile LAS unsigned* st;
};

__device__ __forceinline__ XcdBarrier xcd_barrier_post(unsigned* bar, volatile LAS unsigned* st) {
    XcdBarrier b; b.bar = bar; b.x = xb_xcc_id(); b.st = st;
    if (threadIdx.x == 0) (void)xb_add(&bar[XB_XCNT(b.x)], 1u);
    return b;
}
__device__ __forceinline__ void xcd_barrier_complete(unsigned* bar, unsigned x, unsigned& nloc, unsigned& nx) {
    const unsigned G = gridDim.x * gridDim.y * gridDim.z;
    unsigned sum, cnt, mine, sp = 0u;
    for (;;) {
        sum = 0u; cnt = 0u; mine = 0u;
#pragma unroll
        for (unsigned j = 0; j < 16; ++j) { const unsigned c = xb_ld(&bar[XB_XCNT(j)]); sum += c; cnt += (c > 0u) ? 1u : 0u; mine = (j == x) ? c : mine; }
        if (sum == G) break;
        __builtin_amdgcn_s_sleep(1);
        if ((++sp & 255u) == 0u) { if (xb_ld(&bar[XB_TMO])) break; if (sp > XB_SPIN_CAP) { (void)xb_add(&bar[XB_TMO], 1u); break; } }
    }
    nloc = mine > 0u ? mine : 1u; nx = cnt > 0u ? cnt : 1u;
}

__device__ __attribute__((noinline)) void xcd_barrier(const XcdBarrier b) {
    asm volatile("s_waitcnt vmcnt(0)" ::: "memory");
    __syncthreads();
    if (threadIdx.x == 0) {
        unsigned* bar = b.bar;
        __builtin_amdgcn_s_waitcnt(0);
        unsigned nloc = b.st[0], nx = b.st[1];
        if (nloc == 0u) { xcd_barrier_complete(bar, b.x, nloc, nx); b.st[0] = nloc; b.st[1] = nx; }
        const unsigned old = xb_add(&bar[XB_XSUB(b.x)], 1u);
        const unsigned gen = old / nloc;
        if (old + 1u == (gen + 1u) * nloc) {
            __builtin_amdgcn_fence(__ATOMIC_RELEASE, "agent");
            asm volatile("s_waitcnt vmcnt(0)" ::: "memory");
            const unsigned og = xb_add(&bar[XB_TOP], 1u);
            const unsigned tg = og / nx;
            if (og + 1u == (tg + 1u) * nx) xb_add(&bar[XB_TOPGEN], 1u);
            else XB_SPIN(xb_ld(&bar[XB_TOPGEN]) == tg, bar);
            __builtin_amdgcn_fence(__ATOMIC_ACQUIRE, "agent");
            xb_add(&bar[XB_XGEN(b.x)], 1u);
            asm volatile("s_waitcnt vmcnt(0)" ::: "memory");
        } else {
            XB_SPIN(xb_ld(&bar[XB_XGEN(b.x)]) == gen, bar);
            __builtin_amdgcn_fence(__ATOMIC_ACQUIRE, "agent");
            asm volatile("s_waitcnt vmcnt(0)" ::: "memory");
        }
    }
    __syncthreads();
}

#ifndef DENSE_FP8
#define DENSE_FP8 1
#endif
#ifndef WGM_INPROJ
#define WGM_INPROJ 4
#endif
#ifndef WGM_WO
#define WGM_WO 4
#endif
#ifndef WGM_DUP
#define WGM_DUP 4
#endif
#ifndef WGM_DDOWN
#define WGM_DDOWN 4
#endif
#ifndef WGM_MUP
#define WGM_MUP 4
#endif
#ifndef WGM_MDOWN
#define WGM_MDOWN 4
#endif
#ifndef CONV_SPLIT
#define CONV_SPLIT 1
#endif
#ifndef CONV_CUS_A
#define CONV_CUS_A 64
#endif
#ifndef CONV_CUS_B
#define CONV_CUS_B 32
#endif
#ifndef CONV_KEEP_PCT
#define CONV_KEEP_PCT 18
#endif
#ifndef CONV_A_PCT
#define CONV_A_PCT 54
#endif
#ifndef MOE_SPLIT
#define MOE_SPLIT 1
#endif
__device__ __forceinline__ int moe_split_s(int nR, int G) { int s = 1; if (nR * 8 * 2 <= G) s = 2; if (nR * 8 * 4 <= G) s = 4; if (nR * 8 * 7 <= G) s = 7; if (nR * 8 * 14 <= G) s = 14; return s; }
enum { I_x, I_c, I_attn_norm_g, I_ada_w, I_ada_b, I_w_in, I_forget_b, I_moba_out_g, I_fox_out_g, I_w_o, I_ffn_norm_g, I_dense_w_gate, I_dense_w_up, I_dense_w_down,
       I_router_w, I_moe_w_gate, I_moe_w_up, I_moe_w_down, I_final_norm_g, N_IN };
struct Args { const float* in[N_IN]; float* out; unsigned char* ws; };
__device__ __forceinline__ const float* inp(const unsigned char* ws, int i) {
    const unsigned long long v = __hip_atomic_load((GAS unsigned long long*)(ws + WS_TAB) + i, __ATOMIC_RELAXED, __HIP_MEMORY_SCOPE_AGENT);
    const unsigned lo = (unsigned)__builtin_amdgcn_readfirstlane((int)(unsigned)v), hi = (unsigned)__builtin_amdgcn_readfirstlane((int)(unsigned)(v >> 32));
    return (const float*)(((unsigned long long)hi << 32) | lo);
}
#define INP(name) inp(a.ws, I_##name)
struct Frame {
    LAS unsigned char* lds; volatile LAS unsigned* MISC; gu32* ctl;
    int tid, lane, wave, vcu, G;
};

template <int MAP> __device__ __forceinline__ int map_row(int c) {
    if (MAP == 1) { if (c >= 2048) return c; const int d = c & 127, dd = d & 63; return (c & ~127) + 8 * (dd >> 2) + 4 * (d >> 6) + (dd & 3); }
    if (MAP == 2) return (c >> 7) * 256 + (c & 127);
    if (MAP == 3) return (c >> 7) * 256 + 128 + (c & 127);
    return c;
}
template <int MAP>
__device__ __forceinline__ void transpose_item(const float* W, int ldw, int K, int nblk, bf16* WT, const float* kscale, LAS float* scr, int item, int lane) {
    const int kb = item / nblk, nb = item - kb * nblk, k0 = 64 * kb, n0 = 32 * nb;
#pragma unroll
    for (int i = 0; i < 8; ++i) { const int kk = 8 * i + (lane >> 3), c4 = (lane & 7) * 4; f32x4 v = *(const GAS f32x4*)(W + (size_t)(k0 + kk) * ldw + n0 + c4); if (kscale) v = v * kscale[k0 + kk];
        LAS float* d = scr + kk * 33 + c4; d[0] = v.x; d[1] = v.y; d[2] = v.z; d[3] = v.w; }
    LDS_WAIT(); asm volatile("" ::: "memory");
    const int c = lane & 7;
#pragma unroll
    for (int j = 0; j < 4; ++j) { const int n = (lane >> 3) + 8 * j; const LAS float* s = scr + (8 * c) * 33 + n;
        v4u o; o.x = pg8::cvt_pk_bf16(s[0 * 33], s[1 * 33]); o.y = pg8::cvt_pk_bf16(s[2 * 33], s[3 * 33]); o.z = pg8::cvt_pk_bf16(s[4 * 33], s[5 * 33]); o.w = pg8::cvt_pk_bf16(s[6 * 33], s[7 * 33]);
        *(GAS v4u*)(WT + (size_t)map_row<MAP>(n0 + n) * K + k0 + 8 * c) = o; }
    LDS_WAIT(); asm volatile("" ::: "memory");
}
template <int MAP>
__device__ __forceinline__ void transpose_item8(const float* W, int ldw, int K, int nblk, unsigned char* WT, float scale, LAS float* scr, int item, int lane) {
    const int kb = item / nblk, nb = item - kb * nblk, k0 = 128 * kb, n0 = 32 * nb;
#pragma unroll
    for (int i = 0; i < 16; ++i) { const int kk = 8 * i + (lane >> 3), c4 = (lane & 7) * 4; const f32x4 v = *(const GAS f32x4*)(W + (size_t)(k0 + kk) * ldw + n0 + c4) * scale;
        LAS float* d = scr + kk * 33 + c4; d[0] = v.x; d[1] = v.y; d[2] = v.z; d[3] = v.w; }
    LDS_WAIT(); asm volatile("" ::: "memory");
    const int c = lane & 7;
#pragma unroll
    for (int j = 0; j < 4; ++j) { const int n = (lane >> 3) + 8 * j; const LAS float* s = scr + (16 * c) * 33 + n;
        v4u o; o.x = pg8::pk_fp8x4(s[0 * 33], s[1 * 33], s[2 * 33], s[3 * 33]); o.y = pg8::pk_fp8x4(s[4 * 33], s[5 * 33], s[6 * 33], s[7 * 33]);
        o.z = pg8::pk_fp8x4(s[8 * 33], s[9 * 33], s[10 * 33], s[11 * 33]); o.w = pg8::pk_fp8x4(s[12 * 33], s[13 * 33], s[14 * 33], s[15 * 33]);
        *(GAS v4u*)(WT + (size_t)map_row<MAP>(n0 + n) * K + k0 + 16 * c) = o; }
    LDS_WAIT(); asm volatile("" ::: "memory");
}
__device__ __forceinline__ void p0a(Frame& F0, const Args& a) {
    Frame F = F0; asm volatile("" : "+v"(F.tid), "+v"(F.lane));
    LAS float* ca = (LAS float*)(F.lds + RING_OFF);
    for (int i = F.tid; i < NB * DM; i += NWAVES * 64) { const float v = a.in[I_c][i]; ca[i] = v / (1.f + expf(-v)); }
    __syncthreads();
    const int gw = F.vcu * NWAVES + F.wave, NGW = F.G * NWAVES;
    float* part = (float*)(a.ws + WS_PART);
    for (int it = gw; it < 2 * 32 * 48; it += NGW) {
        const int cg = it % 48, lc = it / 48, chunk = lc & 31, l = lc >> 5, j0 = cg * 256 + 4 * F.lane;
        const float* w = a.in[I_ada_w] + ((size_t)l * DM + chunk * 64) * 12288 + j0;
        f32x4 s0 = {0.f, 0.f, 0.f, 0.f}, s1 = s0, s2 = s0, s3 = s0;
#pragma unroll 16
        for (int dd = 0; dd < 64; ++dd) { const f32x4 wv = *(const GAS f32x4*)(w + (size_t)dd * 12288); const int d = chunk * 64 + dd;
            s0 += ca[d] * wv; s1 += ca[DM + d] * wv; s2 += ca[2 * DM + d] * wv; s3 += ca[3 * DM + d] * wv; }
        float* pp = part + ((size_t)(chunk * 2 + l) * 4) * 12288 + j0;
        *(f32x4*)(pp) = s0; *(f32x4*)(pp + 12288) = s1; *(f32x4*)(pp + 2 * 12288) = s2; *(f32x4*)(pp + 3 * 12288) = s3;
    }
    const int gt = F.vcu * (NWAVES * 64) + F.tid, NGT = F.G * NWAVES * 64;
    float* ropeT = (float*)(a.ws + WS_ROPE);
    for (int i = gt; i < SEQ * 64; i += NGT) {
        const int pos = i >> 6, dp = i & 63;
        const float invf = (float)exp2(-(double)(2 * dp) / 128.0 * 13.287712379549449);
        const float angf = (float)pos * invf;
        float* t = ropeT + ((size_t)pos * 16 + (dp >> 2)) * 8 + (dp & 3);
        t[0] = (float)cos((double)angf); t[4] = (float)sin((double)angf);
    }
    float* wfz = (float*)(a.ws + WS_WFZ);
    for (int i = gt; i < NLAYER * 8 * DM; i += NGT) { const int d = i & (DM - 1), j = (i >> 11) & 7, l = i >> 14; wfz[i] = a.in[I_w_in][((size_t)l * DM + d) * INW + NQKV + j]; }
    if (F.tid == 0) { GAS unsigned long long* tab = (GAS unsigned long long*)(a.ws + WS_TAB);
#pragma unroll
        for (int i = 0; i < N_IN; ++i) tab[i] = (unsigned long long)a.in[i]; }
}
__device__ __forceinline__ bool conv_split(int G) { return CONV_SPLIT && DENSE_FP8 && G == 256; }
template <int MODE>
__device__ __forceinline__ void p0b(Frame& F0, const Args& a) {
    Frame F = F0; asm volatile("" : "+v"(F.tid), "+v"(F.lane));
    if (MODE == 0) {
    const int gt = F.vcu * (NWAVES * 64) + F.tid, NGT = F.G * NWAVES * 64;
    const float* part = (const float*)(a.ws + WS_PART); float* mod = (float*)(a.ws + WS_MOD); const float* adab = INP(ada_b);
    for (int i = gt; i < NLAYER * NB * 12288; i += NGT) {
        const int j = i % 12288, l = i / (4 * 12288); float s = adab[l * 12288 + j];
#pragma unroll 8
        for (int ch = 0; ch < 32; ++ch) s += part[(size_t)ch * (8 * 12288) + i];
        mod[i] = s;
    }
    }
    LAS float* scr = (LAS float*)(F.lds + RING_OFF + F.wave * 16896);
    constexpr int CCUS = MODE == 1 ? CONV_CUS_A : CONV_CUS_B;
    const int gw = MODE == 0 ? F.vcu * NWAVES + F.wave : ((int)blockIdx.x - (F.G - CCUS)) * NWAVES + F.wave, NGW = MODE == 0 ? F.G * NWAVES : CCUS * NWAVES;
    constexpr int I_IN = 32 * 192, I_O = 32 * 64, I_GU = 32 * 224, I_D = 112 * 64;
    constexpr int J_GU = 16 * 224, J_D = 56 * 64;
    constexpr int PER8 = 2 * J_GU + J_D, PER16 = 2 * I_GU + I_D, N8 = DENSE_FP8 ? 9 : 8;
    constexpr int NITEMS = NLAYER * (I_IN + I_O) + N8 * PER8 + (DENSE_FP8 ? 0 : PER16);
    const float* p_w_in = INP(w_in); const float* p_w_o = INP(w_o); const float* p_mg = INP(moba_out_g); const float* p_fg = INP(fox_out_g);
    const float* p_dg = INP(dense_w_gate); const float* p_du = INP(dense_w_up); const float* p_dd = INP(dense_w_down);
    const float* p_eg = INP(moe_w_gate); const float* p_eu = INP(moe_w_up); const float* p_ed = INP(moe_w_down);
    unsigned char* wsb = a.ws;
    struct Item { const float* src; unsigned char* dst; const float* ksc; int ldw, K, nload, map, fp8; float scale; };
    auto decode = [&](int it) -> Item {
        Item d; int r = it; d.ksc = nullptr; d.scale = 1.f; d.fp8 = 0; d.nload = 8;
        if (r < NLAYER * I_IN) { const int l = r / I_IN; r -= l * I_IN; const int kb = r / 192, nb = r - kb * 192;
            d.src = p_w_in + (size_t)l * DM * INW + (size_t)(64 * kb) * INW + 32 * nb; d.ldw = INW; d.K = DM; d.map = 1;
            d.dst = wsb + WS_WIN + ((size_t)l * NQKV * DM + 64 * kb) * 2; d.scale = __int_as_float(32 * nb); return d; }
        r -= NLAYER * I_IN;
        if (r < NLAYER * I_O) { const int l = r / I_O; r -= l * I_O; const int kb = r / 64, nb = r - kb * 64;
            d.src = p_w_o + (size_t)l * DM * DM + (size_t)(64 * kb) * DM + 32 * nb; d.ldw = DM; d.K = DM; d.map = 0;
            d.ksc = ((kb < 16) ? p_mg + l * 1024 : p_fg + l * 1024 - 1024) + 64 * kb;
            d.dst = wsb + WS_WO + ((size_t)l * DM * DM + 64 * kb) * 2; d.scale = __int_as_float(32 * nb); return d; }
        r -= NLAYER * I_O;
        if (r < N8 * PER8) { int e = r / PER8; r -= e * PER8; if (!DENSE_FP8) e += 1;
            d.fp8 = 1; d.nload = 16;
            unsigned char* wgu8 = e ? wsb + WS_WGU8 + (size_t)(e - 1) * NGU * DM : wsb + WS_WGU;
            unsigned char* wd8 = e ? wsb + WS_WD8 + (size_t)(e - 1) * DM * DFF : wsb + WS_WD;
            if (r < 2 * J_GU) { const int up = r >= J_GU; if (up) r -= J_GU; const int kb = r / 224, nb = r - kb * 224;
                const float* sp = up ? (e == 0 ? p_du : p_eu + (size_t)(e - 1) * DM * DFF) : (e == 0 ? p_dg : p_eg + (size_t)(e - 1) * DM * DFF);
                d.src = sp + (size_t)(128 * kb) * DFF + 32 * nb; d.ldw = DFF; d.K = DM; d.map = up ? 3 : 2; d.dst = wgu8 + 128 * kb; d.ksc = nullptr; d.scale = __int_as_float(32 * nb); d.fp8 = 1 + 64; return d; }
            r -= 2 * J_GU; { const int kb = r / 64, nb = r - kb * 64; const float* sp = e == 0 ? p_dd : p_ed + (size_t)(e - 1) * DM * DFF;
                d.src = sp + (size_t)(128 * kb) * DM + 32 * nb; d.ldw = DM; d.K = DFF; d.map = 0; d.dst = wd8 + 128 * kb; d.scale = __int_as_float(32 * nb); d.fp8 = 1 + 128; return d; } }
        r -= N8 * PER8;
        if (r < 2 * I_GU) { const int up = r >= I_GU; if (up) r -= I_GU; const int kb = r / 224, nb = r - kb * 224;
            d.src = (up ? p_du : p_dg) + (size_t)(64 * kb) * DFF + 32 * nb; d.ldw = DFF; d.K = DM; d.map = up ? 3 : 2; d.dst = wsb + WS_WGU + (size_t)(64 * kb) * 2; d.scale = __int_as_float(32 * nb); return d; }
        r -= 2 * I_GU; { const int kb = r / 64, nb = r - kb * 64;
            d.src = p_dd + (size_t)(64 * kb) * DM + 32 * nb; d.ldw = DM; d.K = DFF; d.map = 0; d.dst = wsb + WS_WD + (size_t)(64 * kb) * 2; d.scale = __int_as_float(32 * nb); return d; }
    };
    auto load = [&](const Item& d, f32x4 (&buf)[16]) {
        const float* s = d.src + (size_t)(F.lane >> 3) * d.ldw + (F.lane & 7) * 4;
#pragma unroll
        for (int i = 0; i < 8; ++i) buf[i] = *(const GAS f32x4*)(s + (size_t)(8 * i) * d.ldw);
        if (d.nload == 16) {
#pragma unroll
            for (int i = 8; i < 16; ++i) buf[i] = *(const GAS f32x4*)(s + (size_t)(8 * i) * d.ldw); }
    };
    auto mapr = [&](int map, int c) -> int {
        if (map == 1) { if (c >= 2048) return c; const int dd_ = c & 127, d6 = dd_ & 63; return (c & ~127) + 8 * (d6 >> 2) + 4 * (dd_ >> 6) + (d6 & 3); }
        if (map == 2) return (c >> 7) * 256 + (c & 127);
        if (map == 3) return (c >> 7) * 256 + 128 + (c & 127);
        return c; };
    auto process = [&](const Item& d, const f32x4 (&buf)[16]) {
        const int n0 = __float_as_int(d.scale), c4 = (F.lane & 7) * 4, c = F.lane & 7;
        if (d.fp8 & 1) {
            const float sc = (d.fp8 & 128) ? 128.f : 64.f;
#pragma unroll
            for (int i = 0; i < 16; ++i) { const int kk = 8 * i + (F.lane >> 3); const f32x4 v = buf[i] * sc; LAS float* q = scr + kk * 33 + c4; q[0] = v.x; q[1] = v.y; q[2] = v.z; q[3] = v.w; }
            LDS_WAIT(); asm volatile("" ::: "memory");
#pragma unroll
            for (int j = 0; j < 4; ++j) { const int n = (F.lane >> 3) + 8 * j; const LAS float* s = scr + (16 * c) * 33 + n;
                v4u o; o.x = pg8::pk_fp8x4(s[0 * 33], s[1 * 33], s[2 * 33], s[3 * 33]); o.y = pg8::pk_fp8x4(s[4 * 33], s[5 * 33], s[6 * 33], s[7 * 33]);
                o.z = pg8::pk_fp8x4(s[8 * 33], s[9 * 33], s[10 * 33], s[11 * 33]); o.w = pg8::pk_fp8x4(s[12 * 33], s[13 * 33], s[14 * 33], s[15 * 33]);
                *(GAS v4u*)(d.dst + (size_t)mapr(d.map, n0 + n) * d.K + 16 * c) = o; }
        } else {
#pragma unroll
            for (int i = 0; i < 8; ++i) { const int kk = 8 * i + (F.lane >> 3); f32x4 v = buf[i]; if (d.ksc) v = v * d.ksc[kk]; LAS float* q = scr + kk * 33 + c4; q[0] = v.x; q[1] = v.y; q[2] = v.z; q[3] = v.w; }
            LDS_WAIT(); asm volatile("" ::: "memory");
#pragma unroll
            for (int j = 0; j < 4; ++j) { const int n = (F.lane >> 3) + 8 * j; const LAS float* s = scr + (8 * c) * 33 + n;
                v4u o; o.x = pg8::cvt_pk_bf16(s[0 * 33], s[1 * 33]); o.y = pg8::cvt_pk_bf16(s[2 * 33], s[3 * 33]); o.z = pg8::cvt_pk_bf16(s[4 * 33], s[5 * 33]); o.w = pg8::cvt_pk_bf16(s[6 * 33], s[7 * 33]);
                *(GAS v4u*)(d.dst + ((size_t)mapr(d.map, n0 + n) * d.K + 8 * c) * 2) = o; }
        }
        LDS_WAIT(); asm volatile("" ::: "memory");
    };
    f32x4 bufA[16], bufB[16]; Item cur, nxt;
    constexpr int EARLY0 = NLAYER * (I_IN + I_O) + (DENSE_FP8 ? PER8 : 0), EARLY = EARLY0 + (int)((long long)(NITEMS - EARLY0) * CONV_KEEP_PCT / 100), MID = EARLY + (int)((long long)(NITEMS - EARLY0) * CONV_A_PCT / 100);
    const bool sp = conv_split(F.G);
    const int lo = MODE == 0 ? 0 : MODE == 1 ? EARLY : MID, hi = MODE == 0 ? (sp ? EARLY : NITEMS) : MODE == 1 ? MID : NITEMS;
    int it = lo + gw;
    if (it < hi) { cur = decode(it); load(cur, bufA); }
    while (it < hi) {
        int nit = it + NGW; bool hn = nit < hi;
        if (hn) { nxt = decode(nit); load(nxt, bufB); }
        process(cur, bufA);
        if (!hn) break;
        it = nit; nit = it + NGW; hn = nit < hi;
        if (hn) { cur = decode(nit); load(cur, bufA); }
        process(nxt, bufB);
        if (!hn) break;
        it = nit;
    }
}
__device__ __forceinline__ float reduce8(const float (&v)[8], int lane) {
    float a[4], b[2], c;
    const bool u32 = (lane & 32) != 0, u16 = (lane & 16) != 0, u8 = (lane & 8) != 0;
#pragma unroll
    for (int i = 0; i < 4; ++i) { const float send = u32 ? v[i] : v[i + 4], keep = u32 ? v[i + 4] : v[i]; a[i] = keep + __shfl_xor(send, 32); }
#pragma unroll
    for (int i = 0; i < 2; ++i) { const float send = u16 ? a[i] : a[i + 2], keep = u16 ? a[i + 2] : a[i]; b[i] = keep + __shfl_xor(send, 16); }
    { const float send = u8 ? b[0] : b[1], keep = u8 ? b[1] : b[0]; c = keep + __shfl_xor(send, 8); }
    c += __shfl_xor(c, 4); c += __shfl_xor(c, 2); c += __shfl_xor(c, 1);
    return c;
}
template <int MODE, bool XB16>
__device__ __forceinline__ void norm_phase(Frame& F0, const Args& a, const void* xin_  , const float* g, const float* modl  , int shc  ,
                                           const float* aux  , const float* fb, bf16* H) {
    Frame F = F0; asm volatile("" : "+v"(F.tid), "+v"(F.lane));
    LAS float* A = (LAS float*)(F.lds + RING_OFF); LAS float* B = A + DM; LAS float* W = B + DM;
    LAS int* rt = (LAS int*)(W + 8 * DM);
    if (MODE == 0) { for (int i = F.tid; i < 2 * DM; i += NWAVES * 64) *(LAS f32x4*)(W + 4 * i) = *(const GAS f32x4*)(aux + 4 * i);
        float* ks = (float*)(a.ws + WS_KMEAN); for (int i = F.vcu * (NWAVES * 64) + F.tid; i < 32 * 16 * 128; i += F.G * NWAVES * 64) ks[i] = 0.f; }
    if (MODE == 1) { for (int d = F.tid; d < DM; d += NWAVES * 64) { const f32x4 r0 = *(const GAS f32x4*)(aux + 8 * d), r1 = *(const GAS f32x4*)(aux + 8 * d + 4);
            W[d] = r0.x; W[DM + d] = r0.y; W[2 * DM + d] = r0.z; W[3 * DM + d] = r0.w; W[4 * DM + d] = r1.x; W[5 * DM + d] = r1.y; W[6 * DM + d] = r1.z; W[7 * DM + d] = r1.w; } }
    constexpr bool F8OUT = (MODE == 1) || (MODE == 2 && DENSE_FP8);
    int lastb = -1;
    for (int chunk = F.vcu; chunk < NTOK / 64; chunk += F.G) {
        const int b = chunk >> 6;
        if (b != lastb) { __syncthreads();
            for (int i = F.tid; i < DM; i += NWAVES * 64) { A[i] = g[i] * (1.f + modl[(size_t)b * 12288 + (shc + 1) * DM + i]); B[i] = modl[(size_t)b * 12288 + shc * DM + i]; }
            lastb = b; }
        __syncthreads();
#pragma unroll 1
        for (int rp = 0; rp < 4; ++rp) {
            const int row0 = chunk * 64 + F.wave * 8 + rp * 2;
            f32x4 v[2][8]; float ss[2] = {0.f, 0.f};
            if (!XB16) {
#pragma unroll
                for (int r2 = 0; r2 < 2; ++r2) { const GAS f32x4* xr = (const GAS f32x4*)((const float*)xin_ + (size_t)(row0 + r2) * DM) + F.lane;
#pragma unroll
                    for (int j = 0; j < 8; ++j) v[r2][j] = xr[64 * j]; }
            } else { v2u w[2][8];
#pragma unroll
                for (int r2 = 0; r2 < 2; ++r2) { const GAS v2u* xr = (const GAS v2u*)((const bf16*)xin_ + (size_t)(row0 + r2) * DM) + F.lane;
#pragma unroll
                    for (int j = 0; j < 8; ++j) w[r2][j] = xr[64 * j]; }
#pragma unroll
                for (int r2 = 0; r2 < 2; ++r2)
#pragma unroll
                    for (int j = 0; j < 8; ++j) v[r2][j] = (f32x4){__builtin_bit_cast(float, w[r2][j].x << 16), __builtin_bit_cast(float, w[r2][j].x & 0xffff0000u), __builtin_bit_cast(float, w[r2][j].y << 16), __builtin_bit_cast(float, w[r2][j].y & 0xffff0000u)};
            }
#pragma unroll
            for (int r2 = 0; r2 < 2; ++r2)
#pragma unroll
                for (int j = 0; j < 8; ++j) ss[r2] += (v[r2][j].x * v[r2][j].x + v[r2][j].y * v[r2][j].y) + (v[r2][j].z * v[r2][j].z + v[r2][j].w * v[r2][j].w);
#pragma unroll
            for (int o = 1; o < 64; o <<= 1) { ss[0] += __shfl_xor(ss[0], o); ss[1] += __shfl_xor(ss[1], o); }
#pragma unroll
            for (int r2 = 0; r2 < 2; ++r2) {
                const int row = row0 + r2; const float rstd = 1.0f / sqrtf(ss[r2] * (1.f / DM) + EPS);
#pragma unroll
                for (int j = 0; j < 8; ++j) { const f32x4 av = *(const LAS f32x4*)(A + 256 * j + 4 * F.lane), bv = *(const LAS f32x4*)(B + 256 * j + 4 * F.lane);
                    v[r2][j] = v[r2][j] * rstd * av + bv;
                    if (F8OUT) ((GAS unsigned*)((unsigned char*)H + (size_t)row * DM))[64 * j + F.lane] = pg8::pk_fp8x4(v[r2][j].x, v[r2][j].y, v[r2][j].z, v[r2][j].w);
                    else { v2u w; w.x = pg8::cvt_pk_bf16(v[r2][j].x, v[r2][j].y); w.y = pg8::cvt_pk_bf16(v[r2][j].z, v[r2][j].w); ((GAS v2u*)(H + (size_t)row * DM) + F.lane)[64 * j] = w; } }
            }
            float t2[2][8];
            if (MODE != 2) {
                f32x4 wq[2][8];
#pragma unroll
                for (int j = 0; j < 8; ++j) wq[0][j] = *(const LAS f32x4*)(W + 256 * j + 4 * F.lane);
#pragma unroll
                for (int e = 0; e < 8; ++e) { f32x4 s0 = {0.f, 0.f, 0.f, 0.f}, s1 = s0;
                    __builtin_amdgcn_sched_barrier(0);
                    if (e + 1 < 8) {
#pragma unroll
                        for (int j = 0; j < 8; ++j) wq[(e + 1) & 1][j] = *(const LAS f32x4*)(W + (e + 1) * DM + 256 * j + 4 * F.lane); }
                    __builtin_amdgcn_sched_barrier(0);
#pragma unroll
                    for (int j = 0; j < 8; ++j) { s0 += v[0][j] * wq[e & 1][j]; s1 += v[1][j] * wq[e & 1][j]; }
                    t2[0][e] = (s0.x + s0.y) + (s0.z + s0.w); t2[1][e] = (s1.x + s1.y) + (s1.z + s1.w);
                    asm volatile("" : "+v"(t2[0][e]), "+v"(t2[1][e])); }
                __builtin_amdgcn_sched_barrier(0);
            }
#pragma unroll
            for (int r2 = 0; r2 < 2; ++r2) {
                const int row = row0 + r2;
                if (MODE != 2) {
                    const float tot = reduce8(t2[r2], F.lane);
                    if (MODE == 0) {
                        if ((F.lane & 7) == 0) { const int hh = F.lane >> 3; const float z = tot + fb[hh]; const float ls = fminf(z, 0.f) - log1pf(expf(-fabsf(z)));
                            ((float*)(a.ws + WS_LOGF))[((size_t)b * 8 + hh) * SEQ + (row & (SEQ - 1))] = ls; }
                    } else {
                        float lg[8];
#pragma unroll
                        for (int e = 0; e < 8; ++e) lg[e] = __uint_as_float((unsigned)__builtin_amdgcn_readlane((int)__float_as_uint(tot), 8 * e));
                        int i0 = 0, i1 = 0; float v0 = -__builtin_inff(), v1 = -__builtin_inff();
#pragma unroll
                        for (int e = 0; e < 8; ++e) if (lg[e] > v0) { v0 = lg[e]; i0 = e; }
#pragma unroll
                        for (int e = 0; e < 8; ++e) if (e != i0 && lg[e] > v1) { v1 = lg[e]; i1 = e; }
                        const float e1 = expf(v1 - v0), w0 = 1.f / (1.f + e1), w1 = e1 / (1.f + e1);
                        if (F.lane == 0) { int* te = (int*)(a.ws + WS_ROUTE); float* tw = (float*)(a.ws + WS_ROUTE + 131072);
                            te[row * 2] = i0; te[row * 2 + 1] = i1; tw[row * 2] = w0; tw[row * 2 + 1] = w1; rt[(row & 63) * 2] = i0; rt[(row & 63) * 2 + 1] = i1; }
                    }
                }
            }
        }
        if (MODE == 1) {
            __syncthreads();
            if (F.wave == 0) { const int e0 = rt[F.lane * 2], e1 = rt[F.lane * 2 + 1]; int r0 = 0, r1 = 0;
                int* rk = (int*)(a.ws + WS_ROUTE + 2 * 131072); int* cnt = (int*)(a.ws + WS_ROUTE + 4 * 131072);
#pragma unroll
                for (int e = 0; e < 8; ++e) { const unsigned long long bal = __ballot(e0 == e || e1 == e); const int pre = __popcll(bal & ((1ull << F.lane) - 1ull));
                    if (e0 == e) r0 = pre; if (e1 == e) r1 = pre; if (F.lane == 0) cnt[chunk * 8 + e] = __popcll(bal); }
                rk[(chunk * 64 + F.lane) * 2] = r0; rk[(chunk * 64 + F.lane) * 2 + 1] = r1; }
        }
    }
    __syncthreads();
}
__device__ __forceinline__ void outnorm_phase(Frame& F0, const Args& a) {
    Frame F = F0; asm volatile("" : "+v"(F.tid), "+v"(F.lane));
    bf16* ob = (bf16*)(a.ws + WS_O);
    for (int row = F.vcu * NWAVES + F.wave; row < NTOK; row += F.G * NWAVES) {
        GAS v4u* p = (GAS v4u*)(ob + (size_t)row * DM) + F.lane; v4u w[4]; float f[4][8]; float ss0 = 0.f, ss1 = 0.f;
#pragma unroll
        for (int j = 0; j < 4; ++j) w[j] = p[64 * j];
#pragma unroll
        for (int j = 0; j < 4; ++j) { const unsigned u4[4] = {w[j].x, w[j].y, w[j].z, w[j].w}; float s = 0.f;
#pragma unroll
            for (int q = 0; q < 4; ++q) { f[j][2 * q] = bf2f((unsigned short)(u4[q] & 0xffffu)); f[j][2 * q + 1] = bf2f((unsigned short)(u4[q] >> 16)); s += f[j][2 * q] * f[j][2 * q] + f[j][2 * q + 1] * f[j][2 * q + 1]; }
            if (j < 2) ss0 += s; else ss1 += s; }
        const float r0 = 1.0f / sqrtf(wave_sum(ss0) * (1.f / 1024.f) + EPS), r1 = 1.0f / sqrtf(wave_sum(ss1) * (1.f / 1024.f) + EPS);
#pragma unroll
        for (int j = 0; j < 4; ++j) { const float r = j < 2 ? r0 : r1; v4u o; o.x = pk2(f[j][0] * r, f[j][1] * r); o.y = pk2(f[j][2] * r, f[j][3] * r); o.z = pk2(f[j][4] * r, f[j][5] * r); o.w = pk2(f[j][6] * r, f[j][7] * r); p[64 * j] = o; }
    }
}
__device__ __forceinline__ void moe_gather_phase(Frame& F0, const Args& a) {
    Frame F = F0; asm volatile("" : "+v"(F.tid), "+v"(F.lane));
    LAS int* tile_e = (LAS int*)(F.lds + TILE_E_OFF);
    LAS int* sh = (LAS int*)(F.lds + RING_OFF);
    const int* cnt = (const int*)(a.ws + WS_ROUTE + 4 * 131072); const int* te = (const int*)(a.ws + WS_ROUTE); const int* rk = (const int*)(a.ws + WS_ROUTE + 2 * 131072);
    int* slot = (int*)(a.ws + WS_ROUTE + 3 * 131072);
    const bf16* H = (const bf16*)(a.ws + WS_H); bf16* HS = (bf16*)(a.ws + WS_HS);
    for (int chunk = F.vcu; chunk < NTOK / 64; chunk += F.G) {
        __syncthreads();
        if (F.wave == 0) {
            int tot[8], bef[8];
#pragma unroll
            for (int e = 0; e < 8; ++e) { tot[e] = 0; bef[e] = 0; }
            for (int c = F.lane; c < 256; c += 64) {
#pragma unroll
                for (int e = 0; e < 8; ++e) { const int v = cnt[c * 8 + e]; tot[e] += v; if (c < chunk) bef[e] += v; } }
#pragma unroll
            for (int e = 0; e < 8; ++e) {
#pragma unroll
                for (int o = 1; o < 64; o <<= 1) { tot[e] += __shfl_xor(tot[e], o); bef[e] += __shfl_xor(bef[e], o); } }
            if (F.lane == 0) { int off = 0;
#pragma unroll
                for (int e = 0; e < 8; ++e) { sh[e] = tot[e]; sh[8 + e] = off; sh[32 + e] = bef[e]; const int nt = (tot[e] + 255) >> 8;
                    for (int t = 0; t < nt; ++t) tile_e[(off >> 8) + t] = e; off += nt << 8; }
                sh[16] = off; tile_e[140] = off >> 8; }
        }
        __syncthreads();
        LAS int* sl = sh + 64;
        if (F.wave == 0) { const int t = chunk * 64 + F.lane;
#pragma unroll
            for (int k = 0; k < 2; ++k) { const int e = te[t * 2 + k]; const int s = sh[8 + e] + sh[32 + e] + rk[t * 2 + k]; slot[t * 2 + k] = s; sl[F.lane * 2 + k] = s; } }
        __syncthreads();
        for (int cp0 = F.wave; cp0 < 128; cp0 += 4 * NWAVES) {
            v4u w[4][2];
#pragma unroll
            for (int q = 0; q < 4; ++q) { const int cp = cp0 + q * NWAVES, tl = cp >> 1; const GAS v4u* src = (const GAS v4u*)((const unsigned char*)H + (size_t)(chunk * 64 + tl) * DM) + F.lane;
#pragma unroll
                for (int j = 0; j < 2; ++j) w[q][j] = src[64 * j]; }
#pragma unroll
            for (int q = 0; q < 4; ++q) { const int s = sl[cp0 + q * NWAVES]; GAS v4u* dst = (GAS v4u*)((unsigned char*)HS + (size_t)s * DM) + F.lane;
#pragma unroll
                for (int j = 0; j < 2; ++j) dst[64 * j] = w[q][j]; } }
    }
    __syncthreads();
}
__device__ __forceinline__ void final_phase(Frame& F0, const Args& a, const bf16* x1  , const float* gf  , float* outp) {
    Frame F = F0; asm volatile("" : "+v"(F.tid), "+v"(F.lane));
    const float* fng = INP(final_norm_g);
    const LAS int* tile_e_ = (const LAS int*)(F.lds + TILE_E_OFF); const int nM_ = __builtin_amdgcn_readfirstlane(tile_e_[140]);
    const int nR_ = MOE_SPLIT ? nM_ % 32 : 0, nF256 = (nM_ - nR_) * 256, SS_ = nR_ ? moe_split_s(nR_, F.G) : 1; const float* YP = (const float*)(a.ws + WS_YP);
    const bf16* YS = (const bf16*)(a.ws + WS_YS); const int* slot = (const int*)(a.ws + WS_ROUTE + 3 * 131072); const float* tw = (const float*)(a.ws + WS_ROUTE + 131072);
    f32x4 fgv[8];
#pragma unroll
    for (int j = 0; j < 4; ++j) { fgv[2 * j] = ((const GAS f32x4*)fng)[128 * j + 2 * F.lane]; fgv[2 * j + 1] = ((const GAS f32x4*)fng)[128 * j + 2 * F.lane + 1]; }
    const int stride = F.G * NWAVES, rowA = F.vcu * NWAVES + F.wave;
    int sa0 = slot[rowA * 2], sa1 = slot[rowA * 2 + 1]; float wa0 = tw[rowA * 2], wa1 = tw[rowA * 2 + 1];
    int sb0 = 0, sb1 = 0; float wb0 = 0.f, wb1 = 0.f;
    if (rowA + stride < NTOK) { const int r_ = rowA + stride; sb0 = slot[r_ * 2]; sb1 = slot[r_ * 2 + 1]; wb0 = tw[r_ * 2]; wb1 = tw[r_ * 2 + 1]; }
    v4u xw[4], yv[2][4]; f32x4 gv[8];
#define FINAL_LOADS(ROW, S0, S1) do { const GAS v4u* xr_ = (const GAS v4u*)(x1 + (size_t)(ROW) * DM) + F.lane; const GAS v4u* y0_ = (const GAS v4u*)(YS + (size_t)(S0) * DM) + F.lane; const GAS v4u* y1_ = (const GAS v4u*)(YS + (size_t)(S1) * DM) + F.lane; \
        const GAS f32x4* gp_ = (const GAS f32x4*)(gf + (size_t)((ROW) >> 12) * 12288); \
        _Pragma("unroll") for (int j = 0; j < 4; ++j) { xw[j] = xr_[64 * j]; yv[0][j] = y0_[64 * j]; yv[1][j] = y1_[64 * j]; } \
        _Pragma("unroll") for (int j = 0; j < 4; ++j) { gv[2 * j] = gp_[128 * j + 2 * F.lane]; gv[2 * j + 1] = gp_[128 * j + 2 * F.lane + 1]; } } while (0)
    FINAL_LOADS(rowA, sa0, sa1);
#pragma unroll 1
    for (int row = rowA; row < NTOK; row += stride) {
        f32x4 v[8]; float s = 0.f; float yy[4][8];
#pragma unroll
        for (int j = 0; j < 4; ++j) {
#pragma unroll
            for (int q = 0; q < 8; ++q) yy[j][q] = 0.f; }
#pragma unroll
        for (int k = 0; k < 2; ++k) {
            const int sk = k ? sa1 : sa0; const float wk = k ? wa1 : wa0;
            if (sk < nF256) {
#pragma unroll
                for (int j = 0; j < 4; ++j) { const unsigned u4[4] = {yv[k][j].x, yv[k][j].y, yv[k][j].z, yv[k][j].w};
#pragma unroll
                    for (int q = 0; q < 4; ++q) { yy[j][2 * q] += __builtin_bit_cast(float, u4[q] << 16) * wk; yy[j][2 * q + 1] += __builtin_bit_cast(float, u4[q] & 0xffff0000u) * wk; } }
            } else {
                for (int ks = 0; ks < SS_; ++ks) { const GAS f32x4* pr = (const GAS f32x4*)(YP + ((size_t)ks * nR_ * 256 + (sk - nF256)) * DM);
#pragma unroll
                    for (int j = 0; j < 4; ++j) { const f32x4 p0 = pr[128 * j + 2 * F.lane], p1 = pr[128 * j + 2 * F.lane + 1];
                        yy[j][0] += p0.x * wk; yy[j][1] += p0.y * wk; yy[j][2] += p0.z * wk; yy[j][3] += p0.w * wk; yy[j][4] += p1.x * wk; yy[j][5] += p1.y * wk; yy[j][6] += p1.z * wk; yy[j][7] += p1.w * wk; } }
            }
        }
#pragma unroll
        for (int j = 0; j < 4; ++j) { const float (&y)[8] = yy[j]; const v4u w = xw[j];
            const f32x4 xa = {__builtin_bit_cast(float, w.x << 16), __builtin_bit_cast(float, w.x & 0xffff0000u), __builtin_bit_cast(float, w.y << 16), __builtin_bit_cast(float, w.y & 0xffff0000u)};
            const f32x4 xb = {__builtin_bit_cast(float, w.z << 16), __builtin_bit_cast(float, w.z & 0xffff0000u), __builtin_bit_cast(float, w.w << 16), __builtin_bit_cast(float, w.w & 0xffff0000u)};
            v[2 * j] = xa + gv[2 * j] * (f32x4){y[0], y[1], y[2], y[3]}; v[2 * j + 1] = xb + gv[2 * j + 1] * (f32x4){y[4], y[5], y[6], y[7]};
            s += (v[2 * j].x * v[2 * j].x + v[2 * j].y * v[2 * j].y) + (v[2 * j].z * v[2 * j].z + v[2 * j].w * v[2 * j].w) + (v[2 * j + 1].x * v[2 * j + 1].x + v[2 * j + 1].y * v[2 * j + 1].y) + (v[2 * j + 1].z * v[2 * j + 1].z + v[2 * j + 1].w * v[2 * j + 1].w); }
        __builtin_amdgcn_sched_barrier(0);
        { const int nr = row + stride;
          if (nr < NTOK) { FINAL_LOADS(nr, sb0, sb1); }
          sa0 = sb0; sa1 = sb1; wa0 = wb0; wa1 = wb1;
          const int nnr = nr + stride; if (nnr < NTOK) { sb0 = slot[nnr * 2]; sb1 = slot[nnr * 2 + 1]; wb0 = tw[nnr * 2]; wb1 = tw[nnr * 2 + 1]; } }
        __builtin_amdgcn_sched_barrier(0);
        const float rstd = 1.0f / sqrtf(wave_sum(s) * (1.f / DM) + EPS);
        GAS f32x4* o = (GAS f32x4*)(outp + (size_t)row * DM);
#pragma unroll
        for (int j = 0; j < 4; ++j) { o[128 * j + 2 * F.lane] = v[2 * j] * rstd * fgv[2 * j]; o[128 * j + 2 * F.lane + 1] = v[2 * j + 1] * rstd * fgv[2 * j + 1]; }
    }
#undef FINAL_LOADS
}

#ifndef REP_NORM3
#define REP_NORM3 1
#endif
#ifndef REP_FINAL
#define REP_FINAL 1
#endif
#ifndef REP_NORM2
#define REP_NORM2 1
#endif
#ifndef EXTRA_BARS
#define EXTRA_BARS 0
#endif
#ifndef REP_P0
#define REP_P0 1
#endif
#ifndef REP_INPROJ
#define REP_INPROJ 1
#endif
#ifndef REP_ATTN
#define REP_ATTN 1
#endif
#ifndef REP_WO
#define REP_WO 1
#endif
#ifndef REP_DUP
#define REP_DUP 1
#endif
#ifndef REP_DDOWN
#define REP_DDOWN 1
#endif
#ifndef REP_MUP
#define REP_MUP 1
#endif
#ifndef REP_MDOWN
#define REP_MDOWN 1
#endif
#ifndef REP_NORM1
#define REP_NORM1 1
#endif
#ifndef REP_SCAN
#define REP_SCAN 1
#endif
#ifndef REP_OUTNORM
#define REP_OUTNORM 1
#endif
#ifndef REP_GATHER
#define REP_GATHER 1
#endif
#ifndef PH_P0
#define PH_P0 1
#endif
#ifndef PH_NORM1
#define PH_NORM1 1
#endif
#ifndef PH_INPROJ
#define PH_INPROJ 1
#endif
#ifndef PH_SCAN
#define PH_SCAN 1
#endif
#ifndef PH_MOBA
#define PH_MOBA 1
#endif
#ifndef PH_FOX
#define PH_FOX 1
#endif
#ifndef PH_OUTNORM
#define PH_OUTNORM 1
#endif
#ifndef PH_WO
#define PH_WO 1
#endif
#ifndef PH_NORM2
#define PH_NORM2 1
#endif
#ifndef PH_DUP
#define PH_DUP 1
#endif
#ifndef PH_DDOWN
#define PH_DDOWN 1
#endif
#ifndef PH_NORM3
#define PH_NORM3 1
#endif
#ifndef PH_GATHER
#define PH_GATHER 1
#endif
#ifndef PH_MUP
#define PH_MUP 1
#endif
#ifndef PH_MDOWN
#define PH_MDOWN 1
#endif
#ifndef PH_FINAL
#define PH_FINAL 1
#endif
template <int l>
__device__ __forceinline__ void layer_body(Frame& F, const Args& args, const XcdBarrier& bar) {
    unsigned char* ws = args.ws;
    bf16* H = (bf16*)(ws + WS_H); bf16* QKV = (bf16*)(ws + WS_QKV); bf16* OB = (bf16*)(ws + WS_O);
    const float* mod = (const float*)(ws + WS_MOD);
#define GRID_BAR() xcd_barrier(bar)
        const float* modl = mod + (size_t)l * NB * 12288;
        bf16* XB = (bf16*)(ws + WS_XB);
        const void* xin = (l == 0) ? (const void*)inp(ws, I_x) : (const void*)XB;
#if PH_NORM1
for (int rep_ = 0; rep_ < REP_NORM1; ++rep_) {
        norm_phase<0, l != 0>(F, args, xin, inp(ws, I_attn_norm_g) + l * DM, modl, 0, (const float*)(ws + WS_WFZ) + (size_t)l * 8 * DM, inp(ws, I_forget_b) + l * 8, H);
#endif
        GRID_BAR();
}
#if PH_INPROJ
for (int rep_ = 0; rep_ < REP_INPROJ; ++rep_) {
        if (l == 0 && conv_split(F.G) && (int)blockIdx.x >= F.G - CONV_CUS_A) p0b<1>(F, args);
        else { const int Gg = (l == 0 && conv_split(F.G)) ? F.G - CONV_CUS_A : F.G;
          pg8::Gemm g{H, (const bf16*)(ws + WS_WIN) + (size_t)l * NQKV * DM, NTOK, NQKV, DM, 0, 0}; pg8::StaticOrder S; S.init(NTOK, NQKV, Gg, (int)blockIdx.x, WGM_INPROJ);
          pg8::EpiQKV E{QKV, NQKV, (const float*)(ws + WS_ROPE), (float*)(ws + WS_KMEAN)};
          pg8::gemm_phase<pg8::EpiQKV, pg8::StaticOrder, true, true>(F.lds + RING_OFF, g, S, E); }
#endif
        GRID_BAR();
}

for (int rep_ = 0; rep_ < REP_ATTN; ++rep_) {
        { const att::Tensors T{QKV, OB, (const float*)(ws + WS_LOGF), (const float*)(ws + WS_KMEAN), (float*)(ws + WS_FBIAS)};
#if PH_MOBA
          att::attn_phase<0>((LAS char*)(F.lds + RING_OFF), T, F.vcu, F.G);
#endif
#if PH_FOX
          att::attn_phase<1>((LAS char*)(F.lds + RING_OFF), T, F.vcu, F.G);
#endif
          (void)T; }
        GRID_BAR();
}

#if PH_WO
for (int rep_ = 0; rep_ < REP_WO; ++rep_) {
        { pg8::Gemm g{OB, (const bf16*)(ws + WS_WO) + (size_t)l * DM * DM, NTOK, DM, DM, 0, 0}; pg8::StaticOrder S; S.init(NTOK, DM, F.G, (int)blockIdx.x, WGM_WO);
          LAS float* rs = (LAS float*)(F.lds + RS_OFF);
          { int tid_ = F.tid; asm volatile("" : "+v"(tid_)); pg8::Unit uu; const float* ssq = (const float*)(ws + WS_FBIAS);
            for (int i = 0; i < RS_UNITS; ++i) if (S.next(i, uu) && tid_ < 256) { const f32x4* q = (const f32x4*)(ssq + (size_t)(uu.pm * 256 + tid_) * 16); const f32x4 a0 = q[0], a1 = q[1], a2 = q[2], a3 = q[3];
                const float sm = ((a0[0] + a0[1]) + (a0[2] + a0[3])) + ((a1[0] + a1[1]) + (a1[2] + a1[3])), sf = ((a2[0] + a2[1]) + (a2[2] + a2[3])) + ((a3[0] + a3[1]) + (a3[2] + a3[3]));
                const float rf = 1.0f / sqrtf(sf * (1.f / 1024.f) + EPS), rm = 1.0f / sqrtf(sm * (1.f / 1024.f) + EPS);
                rs[(i * 256 + tid_) * 2] = rm / rf; rs[(i * 256 + tid_) * 2 + 1] = rf; }
            __syncthreads(); }
          pg8::EpiResidB<l == 0, true> E{xin, rep_ ? (bf16*)(ws + WS_YS) : XB, modl + 2 * DM, 1.f, rs};
          pg8::gemm_phase<pg8::EpiResidB<l == 0, true>, pg8::StaticOrder, true, true>(F.lds + RING_OFF, g, S, E); }
#endif
        GRID_BAR();
}
        if (l == 0) {
#if PH_NORM2
for (int rep_ = 0; rep_ < REP_NORM2; ++rep_) {
            norm_phase<2, true>(F, args, XB, inp(ws, I_ffn_norm_g) + l * DM, modl, 3, nullptr, nullptr, H);
#endif
            GRID_BAR();
}
for (int xb_ = 0; xb_ < EXTRA_BARS; ++xb_) GRID_BAR();
#if PH_DUP
for (int rep_ = 0; rep_ < REP_DUP; ++rep_) {
#if DENSE_FP8
            if (conv_split(F.G) && (int)blockIdx.x >= F.G - CONV_CUS_B) p0b<2>(F, args);
            else { const int Gg = conv_split(F.G) ? F.G - CONV_CUS_B : F.G;
              pg8::Gemm g{H, (const bf16*)(ws + WS_WGU), NTOK, NGU, DM / 2, 0, 0}; pg8::StaticOrder S; S.init(NTOK, NGU, Gg, (int)blockIdx.x, WGM_DUP);
              pg8::EpiSwiGLU8 E{(unsigned char*)(ws + WS_ACT), DFF, 1.f / 64.f};
              pg8::gemm_phase<pg8::EpiSwiGLU8, pg8::StaticOrder, true, true, true>(F.lds + RING_OFF, g, S, E); }
#else
            { pg8::Gemm g{H, (const bf16*)(ws + WS_WGU), NTOK, NGU, DM, 0, 0}; pg8::StaticOrder S; S.init(NTOK, NGU, F.G, (int)blockIdx.x, WGM_DUP);
              pg8::EpiSwiGLU E{(bf16*)(ws + WS_ACT), DFF};
              pg8::gemm_phase<pg8::EpiSwiGLU, pg8::StaticOrder, true, true>(F.lds + RING_OFF, g, S, E); }
#endif
#endif
            GRID_BAR();
}
#if PH_DDOWN
for (int rep_ = 0; rep_ < REP_DDOWN; ++rep_) {
#if DENSE_FP8
            { pg8::Gemm g{(const bf16*)(ws + WS_ACT), (const bf16*)(ws + WS_WD), NTOK, DM, DFF / 2, 0, 0}; pg8::StaticOrder S; S.init(NTOK, DM, F.G, (int)blockIdx.x, WGM_DDOWN);
              pg8::EpiResidB<false, false> E{XB, rep_ ? (bf16*)(ws + WS_YS) : XB, modl + 5 * DM, 1.f / 128.f, nullptr};
              pg8::gemm_phase<pg8::EpiResidB<false, false>, pg8::StaticOrder, true, true, true>(F.lds + RING_OFF, g, S, E); }
#else
            { pg8::Gemm g{(const bf16*)(ws + WS_ACT), (const bf16*)(ws + WS_WD), NTOK, DM, DFF, 0, 0}; pg8::StaticOrder S; S.init(NTOK, DM, F.G, (int)blockIdx.x, WGM_DDOWN);
              pg8::EpiResidB<false, false> E{XB, rep_ ? (bf16*)(ws + WS_YS) : XB, modl + 5 * DM, 1.f, nullptr};
              pg8::gemm_phase<pg8::EpiResidB<false, false>, pg8::StaticOrder, true, true>(F.lds + RING_OFF, g, S, E); }
#endif
#endif
            GRID_BAR();
}
        } else {
#if PH_NORM3
for (int rep_ = 0; rep_ < REP_NORM3; ++rep_) {
            norm_phase<1, true>(F, args, XB, inp(ws, I_ffn_norm_g) + l * DM, modl, 3, inp(ws, I_router_w), nullptr, H);
#endif
            GRID_BAR();
}
#if PH_GATHER
for (int rep_ = 0; rep_ < REP_GATHER; ++rep_) {
            moe_gather_phase(F, args);
#endif
            GRID_BAR();
}
            const LAS int* tile_e = (const LAS int*)(F.lds + TILE_E_OFF); const int nM = __builtin_amdgcn_readfirstlane(tile_e[140]);
#if PH_MUP
for (int rep_ = 0; rep_ < REP_MUP; ++rep_) {
            { pg8::Gemm g{(const bf16*)(ws + WS_HS), (const bf16*)(ws + WS_WGU8), MOE_ROWS, NGU, DM / 2, (size_t)NGU * DM, 0}; pg8::MoeOrder S; S.init(nM, NGU, F.G, (int)blockIdx.x, tile_e, WGM_MUP);
              pg8::EpiSwiGLU8 E{(unsigned char*)(ws + WS_ACTM), DFF, 1.f / 64.f};
              pg8::gemm_phase<pg8::EpiSwiGLU8, pg8::MoeOrder, true, true, true>(F.lds + RING_OFF, g, S, E); }
#endif
            GRID_BAR();
}
#if PH_MDOWN
for (int rep_ = 0; rep_ < REP_MDOWN; ++rep_) {
            { const int nR = MOE_SPLIT ? nM % 32 : 0, nF = nM - nR;
              if (nF > 0) { pg8::Gemm g{(const bf16*)(ws + WS_ACTM), (const bf16*)(ws + WS_WD8), MOE_ROWS, DM, DFF / 2, (size_t)DM * DFF, 0}; pg8::MoeOrder S; S.init(nF, DM, F.G, (int)blockIdx.x, tile_e, WGM_MDOWN);
                pg8::EpiBf16S E{(bf16*)(ws + WS_YS), DM, 1.f / 128.f};
                pg8::gemm_phase<pg8::EpiBf16S, pg8::MoeOrder, true, true, true>(F.lds + RING_OFF, g, S, E); }
              if (nR > 0) { const int SS = moe_split_s(nR, F.G);
                pg8::Gemm g{(const bf16*)(ws + WS_ACTM), (const bf16*)(ws + WS_WD8), MOE_ROWS, DM, DFF / 2, (size_t)DM * DFF, 56 / SS};
                pg8::MoeSplitOrder S{nF, nR, SS, F.G, (int)blockIdx.x, (unsigned)(56 / SS) * 128u, tile_e};
                pg8::EpiF32P E{(float*)(ws + WS_YP), nF, nR, 1.f / 128.f};
                pg8::gemm_phase<pg8::EpiF32P, pg8::MoeSplitOrder, true, true, true>(F.lds + RING_OFF, g, S, E); } }
#endif
            GRID_BAR();
}
#if PH_FINAL
for (int rep_ = REP_FINAL - 1; rep_ >= 0; --rep_) {
            final_phase(F, args, XB, modl + 5 * DM, rep_ ? (float*)(ws + WS_ACTM) : args.out);
 if (rep_) GRID_BAR(); }
#endif
        }
#undef GRID_BAR
}
__global__ void __launch_bounds__(NWAVES * 64, 2) mk_fwd(Args args) {
    extern __shared__ __attribute__((aligned(16))) unsigned char lds[];
    Frame F;
    F.lds = (LAS unsigned char*)lds; F.MISC = (volatile LAS unsigned*)(F.lds + MISC_OFF);
    F.tid = threadIdx.x; F.lane = F.tid & 63; F.wave = __builtin_amdgcn_readfirstlane(F.tid >> 6);
    F.G = gridDim.x; { const int bx = blockIdx.x; F.vcu = (F.G % 8 == 0) ? (bx % 8) * (F.G / 8) + bx / 8 : bx; }
    unsigned char* ws = args.ws;
    F.ctl = (gu32*)(ws + WS_CTL);
    for (int u = F.tid; u < (LDS_BYTES - LDSCTL_OFF) / 4; u += NWAVES * 64) ((LAS unsigned*)(F.lds + LDSCTL_OFF))[u] = 0u;
    __syncthreads();
    XcdBarrier bar = xcd_barrier_post((unsigned*)(F.ctl + CW_BAR), F.MISC + 8);
#define GRID_BAR() xcd_barrier(bar)
    bf16* H = (bf16*)(ws + WS_H); bf16* QKV = (bf16*)(ws + WS_QKV); bf16* OB = (bf16*)(ws + WS_O);
    const float* mod = (const float*)(ws + WS_MOD);

#if PH_P0
for (int rep_ = 0; rep_ < REP_P0; ++rep_) {
    p0a(F, args); GRID_BAR();
    p0b<0>(F, args); GRID_BAR();
}
#endif

    layer_body<0>(F, args, bar);
    layer_body<1>(F, args, bar);
}

extern "C" void kernel_launch(void* const* d_in, const int* in_sizes, int n_in, void* d_out, int out_size, void* d_ws, size_t ws_size, hipStream_t stream) {
    static int grid = 0;
    if (grid == 0) {
        if (n_in != 19 || out_size != NTOK * DM || ws_size < WS_END) { fprintf(stderr, "kernel_launch: unexpected shapes (n_in %d out %d ws %zu, need %zu); nothing launched\n", n_in, out_size, ws_size, (size_t)WS_END); grid = -1; return; }
        int dev = 0, cus = 0, per_cu = 0;
        if (hipGetDevice(&dev) != hipSuccess || hipDeviceGetAttribute(&cus, hipDeviceAttributeMultiprocessorCount, dev) != hipSuccess) { grid = -1; return; }
        if (hipFuncSetAttribute((const void*)mk_fwd, hipFuncAttributeMaxDynamicSharedMemorySize, LDS_BYTES) != hipSuccess) { fprintf(stderr, "kernel_launch: hipFuncSetAttribute failed\n"); grid = -1; return; }
        if (hipOccupancyMaxActiveBlocksPerMultiprocessor(&per_cu, (const void*)mk_fwd, NWAVES * 64, LDS_BYTES) != hipSuccess || per_cu < 1) fprintf(stderr, "kernel_launch: note: occupancy query reports %d\n", per_cu);
        (void)hipGetLastError();
        grid = cus;
    }
    if (grid < 0) return;
    if (hipMemsetAsync((char*)d_ws + WS_CTL, 0, CTL_ZERO_BYTES, stream) != hipSuccess) return;
    Args a{};
    for (int i = 0; i < N_IN; ++i) a.in[i] = (const float*)d_in[i];
    a.out = (float*)d_out; a.ws = (unsigned char*)d_ws;
    hipLaunchKernelGGL(mk_fwd, dim3(grid), dim3(NWAVES * 64), LDS_BYTES, stream, a);
}
```

```cpp
#include <hip/hip_runtime.h>
#include <cstdio>
#include <cstdint>
#include <cmath>
namespace pg8 {
#define PG8_LAS __attribute__((address_space(3)))
typedef unsigned short bf16_t;
typedef short bf16x8 __attribute__((ext_vector_type(8)));
typedef float f32x4 __attribute__((ext_vector_type(4)));
typedef unsigned u32x4 __attribute__((ext_vector_type(4)));
constexpr int BM = 256, BK = 64, HALF = 128, HTB = HALF * BK * 2  , STAGE_BYTES = 8 * HTB, NXCD = 8, WGM = 8;

__host__ __device__ __forceinline__ int lds_byte(int r, int c) { const int st = (r >> 4) * 2 + (c >> 5), rr = r & 15, cc = c & 31, ob = rr * 64 + cc * 2; return st * 1024 + (ob ^ (((ob >> 9) & 1) << 5)); }
__host__ __device__ __forceinline__ void stage_rc(int b, int& R, int& C) { const int st = b / 1024, sb = b % 1024, swz = sb ^ (((sb >> 9) & 1) << 5); R = (st >> 1) * 16 + swz / 64; C = (st & 1) * 32 + (swz % 64) / 2; }
__host__ __device__ __forceinline__ int perm32(int rho) { const int n = rho >> 4, i = rho & 15; return 8 * (i >> 2) + 4 * n + (i & 3); }

struct Unit { int pm, pn, be, idx; unsigned koff; };
struct Gemm { const bf16_t* A; const bf16_t* Bt; int M, N, K; size_t bstride; int nt; };

struct StaticOrder {
    int nM, nN, nwg, G, c, wgm;
    __host__ __device__ void init(int M, int N, int G_, int c_, int wgm_ = WGM) { nM = M / BM; nN = N / BM; nwg = nM * nN; G = G_; c = c_; wgm = wgm_; }
    __host__ __device__ bool next(int i, Unit& u) const {
        const long L = (long)i * G + c; if (L >= nwg) return false;
        int wgid = (int)L; { const int q = nwg / NXCD, r = nwg % NXCD, xcd = wgid % NXCD, off = wgid / NXCD; wgid = (xcd < r ? xcd * (q + 1) : r * (q + 1) + (xcd - r) * q) + off; }
        const int nig = wgm * nN, gid = wgid / nig, fm = gid * wgm, gsz = (nM - fm) < wgm ? (nM - fm) : wgm;
        u.pm = fm + ((wgid % nig) % gsz); u.pn = (wgid % nig) / gsz; u.be = 0; u.idx = i; u.koff = 0u; return true;
    }
    __device__ __forceinline__ void a_ready(const Unit&) const {}
    __device__ __forceinline__ void done(const Unit&) const {}
};

__device__ __forceinline__ unsigned cvt_pk_bf16(float lo, float hi) { unsigned r; asm volatile("v_cvt_pk_bf16_f32 %0, %1, %2" : "=v"(r) : "v"(lo), "v"(hi)); return r; }
typedef float f32x2 __attribute__((ext_vector_type(2)));
typedef int i32x8 __attribute__((ext_vector_type(8)));
typedef int i32x4v __attribute__((ext_vector_type(4)));
__device__ __forceinline__ f32x4 mfma_fp8_128(bf16x8 b0, bf16x8 b1, bf16x8 a0, bf16x8 a1, f32x4 c) {
    const i32x4v bl = __builtin_bit_cast(i32x4v, b0), bh = __builtin_bit_cast(i32x4v, b1), al = __builtin_bit_cast(i32x4v, a0), ah = __builtin_bit_cast(i32x4v, a1);
    const i32x8 B = {bl[0], bl[1], bl[2], bl[3], bh[0], bh[1], bh[2], bh[3]}, A = {al[0], al[1], al[2], al[3], ah[0], ah[1], ah[2], ah[3]};
    asm volatile("v_mfma_f32_16x16x128_f8f6f4 %0, %1, %2, %0" : "+v"(c) : "v"(B), "v"(A));
    return c;
}
__device__ __forceinline__ unsigned pk_fp8x4(float a, float b, float c, float d) { int w = 0; w = __builtin_amdgcn_cvt_pk_fp8_f32(a, b, w, false); w = __builtin_amdgcn_cvt_pk_fp8_f32(c, d, w, true); return (unsigned)w; }

struct EpiQKV {
    static constexpr bool PERM = true, AFTER_DRAIN = false, HAS_MID = false;
    bf16_t* O; int ldc; const float* ropeT; float* ksum;
    __device__ __forceinline__ void operator()(const f32x4 (&acc)[2][2][4][2], const Unit& u, int wr, int wc, int fr, int fq) const {
        const int row0 = u.pm * BM + wr * 64 + fr, col0 = u.pn * BM + wc * 32 + 8 * fq; const bool rope = u.pn < 8, ktile = u.pn >= 4 && u.pn < 8;
        float cs[16];
#pragma unroll
        for (int i = 0; i < 16; ++i) cs[i] = 0.f;
#pragma unroll
        for (int ai = 0; ai < 2; ++ai)
#pragma unroll
            for (int m = 0; m < 4; ++m) { const int row = row0 + ai * HALF + m * 16; bf16_t* rowp = O + (size_t)row * ldc + col0;
                f32x4 c4 = {1.f, 1.f, 1.f, 1.f}, s4 = {0.f, 0.f, 0.f, 0.f};
                if (rope) { const float* rt = ropeT + ((size_t)(row & 4095) * 16 + (wc * 4 + fq)) * 8; c4 = *(const f32x4*)rt; s4 = *(const f32x4*)(rt + 4); }
#pragma unroll
                for (int bj = 0; bj < 2; ++bj) { f32x4 v0 = acc[ai][bj][m][0], v1 = acc[ai][bj][m][1];
                    if (rope) { const f32x4 t1 = v0, t2 = v1; v0 = t1 * c4 - t2 * s4; v1 = t2 * c4 + t1 * s4; }
                    if (ktile) {
#pragma unroll
                        for (int j = 0; j < 4; ++j) { cs[bj * 8 + j] += v0[j]; cs[bj * 8 + 4 + j] += v1[j]; } }
                    u32x4 w; w.x = cvt_pk_bf16(v0[0], v0[1]); w.y = cvt_pk_bf16(v0[2], v0[3]); w.z = cvt_pk_bf16(v1[0], v1[1]); w.w = cvt_pk_bf16(v1[2], v1[3]);
                    *(u32x4*)(rowp + bj * HALF) = w; } }
        if (ktile) {
            float a8[8], a4[4], a2[2], a1;
            const bool b3 = (fr & 8) != 0, b2 = (fr & 4) != 0, b1 = (fr & 2) != 0, b0 = (fr & 1) != 0;
#pragma unroll
            for (int i = 0; i < 8; ++i) { const float send = b3 ? cs[i] : cs[i + 8], keep = b3 ? cs[i + 8] : cs[i]; a8[i] = keep + __shfl_xor(send, 8); }
#pragma unroll
            for (int i = 0; i < 4; ++i) { const float send = b2 ? a8[i] : a8[i + 4], keep = b2 ? a8[i + 4] : a8[i]; a4[i] = keep + __shfl_xor(send, 4); }
#pragma unroll
            for (int i = 0; i < 2; ++i) { const float send = b1 ? a4[i] : a4[i + 2], keep = b1 ? a4[i + 2] : a4[i]; a2[i] = keep + __shfl_xor(send, 2); }
            { const float send = b0 ? a2[0] : a2[1], keep = b0 ? a2[1] : a2[0]; a1 = keep + __shfl_xor(send, 1); }
            const int bj = fr >> 3, n = (fr >> 2) & 1, j = fr & 3;
            const int hd = (u.pn - 4) * 2 + bj, dcol = wc * 32 + 8 * fq + 4 * n + j;
            float* dst = ksum + (((size_t)(u.pm >> 4) * 8 + hd) * 16 + (u.pm & 15)) * 128 + dcol;
            __hip_atomic_fetch_add(dst, a1, __ATOMIC_RELAXED, __HIP_MEMORY_SCOPE_AGENT);
        }
    }
};
struct EpiResid {
    static constexpr bool PERM = false, AFTER_DRAIN = false, HAS_MID = false;
    const float* xin; float* out; const float* gate; float sc;
    __device__ __forceinline__ void operator()(const f32x4 (&acc)[2][2][4][2], const Unit& u, int wr, int wc, int fr, int fq) const {
        const int row0 = u.pm * BM + wr * 64 + fr, col0 = u.pn * BM + wc * 32 + 4 * fq; const float* gp = gate + (size_t)(u.pm >> 4) * 12288 + col0;
        f32x4 gv[2][2];
#pragma unroll
        for (int bj = 0; bj < 2; ++bj)
#pragma unroll
            for (int n = 0; n < 2; ++n) gv[bj][n] = *(const f32x4*)(gp + bj * HALF + n * 16) * sc;
#pragma unroll
        for (int ai = 0; ai < 2; ++ai) { f32x4 pre[4][2][2];
#pragma unroll
            for (int m = 0; m < 4; ++m) { const size_t off = (size_t)(row0 + ai * HALF + m * 16) * 2048 + col0;
#pragma unroll
                for (int bj = 0; bj < 2; ++bj)
#pragma unroll
                    for (int n = 0; n < 2; ++n) pre[m][bj][n] = *(const f32x4*)(xin + off + bj * HALF + n * 16); }
            __builtin_amdgcn_sched_barrier(0);
#pragma unroll
            for (int m = 0; m < 4; ++m) { const size_t off = (size_t)(row0 + ai * HALF + m * 16) * 2048 + col0;
#pragma unroll
                for (int bj = 0; bj < 2; ++bj)
#pragma unroll
                    for (int n = 0; n < 2; ++n) *(f32x4*)(out + off + bj * HALF + n * 16) = pre[m][bj][n] + gv[bj][n] * acc[ai][bj][m][n]; }
            __builtin_amdgcn_sched_barrier(0); }
    }
};
struct EpiResidN {
    static constexpr bool PERM = false, AFTER_DRAIN = false, HAS_MID = true;
    const float* xin; float* out; const float* gate; const PG8_LAS float* rs;
    __device__ __forceinline__ void mid(f32x4 (&acc)[2][2][4][2], const Unit& u, int wr, int wc, int fr, int fq) const {
        const PG8_LAS float* r = rs + (u.idx * 256 + wr * 64 + fr) * 2;
#pragma unroll
        for (int ai = 0; ai < 2; ++ai)
#pragma unroll
            for (int m = 0; m < 4; ++m) { const float ratio = r[(ai * HALF + m * 16) * 2];
#pragma unroll
                for (int bj = 0; bj < 2; ++bj)
#pragma unroll
                    for (int n = 0; n < 2; ++n) acc[ai][bj][m][n] = acc[ai][bj][m][n] * ratio; }
    }
    __device__ __forceinline__ void operator()(const f32x4 (&acc)[2][2][4][2], const Unit& u, int wr, int wc, int fr, int fq) const {
        const int row0 = u.pm * BM + wr * 64 + fr, col0 = u.pn * BM + wc * 32 + 4 * fq; const float* gp = gate + (size_t)(u.pm >> 4) * 12288 + col0;
        const PG8_LAS float* r = rs + (u.idx * 256 + wr * 64 + fr) * 2 + 1;
        f32x4 gv[2][2];
#pragma unroll
        for (int bj = 0; bj < 2; ++bj)
#pragma unroll
            for (int n = 0; n < 2; ++n) gv[bj][n] = *(const f32x4*)(gp + bj * HALF + n * 16);
#pragma unroll
        for (int ai = 0; ai < 2; ++ai) { f32x4 pre[4][2][2];
#pragma unroll
            for (int m = 0; m < 4; ++m) { const size_t off = (size_t)(row0 + ai * HALF + m * 16) * 2048 + col0;
#pragma unroll
                for (int bj = 0; bj < 2; ++bj)
#pragma unroll
                    for (int n = 0; n < 2; ++n) pre[m][bj][n] = *(const f32x4*)(xin + off + bj * HALF + n * 16); }
            __builtin_amdgcn_sched_barrier(0);
#pragma unroll
            for (int m = 0; m < 4; ++m) { const size_t off = (size_t)(row0 + ai * HALF + m * 16) * 2048 + col0; const float rf = r[(ai * HALF + m * 16) * 2];
#pragma unroll
                for (int bj = 0; bj < 2; ++bj)
#pragma unroll
                    for (int n = 0; n < 2; ++n) *(f32x4*)(out + off + bj * HALF + n * 16) = pre[m][bj][n] + gv[bj][n] * (acc[ai][bj][m][n] * rf); }
            __builtin_amdgcn_sched_barrier(0); }
    }
};
template <bool XF32, bool NRM>
struct EpiResidB {
    static constexpr bool PERM = true, AFTER_DRAIN = false, HAS_MID = NRM;
    const void* xin; bf16_t* out; const float* gate; float sc; const PG8_LAS float* rs;
    __device__ __forceinline__ void mid(f32x4 (&acc)[2][2][4][2], const Unit& u, int wr, int wc, int fr, int fq) const {
        const PG8_LAS float* r = rs + (u.idx * 256 + wr * 64 + fr) * 2;
#pragma unroll
        for (int ai = 0; ai < 2; ++ai)
#pragma unroll
            for (int m = 0; m < 4; ++m) { const float ratio = r[(ai * HALF + m * 16) * 2];
#pragma unroll
                for (int bj = 0; bj < 2; ++bj)
#pragma unroll
                    for (int n = 0; n < 2; ++n) acc[ai][bj][m][n] = acc[ai][bj][m][n] * ratio; }
    }
    __device__ __forceinline__ void operator()(const f32x4 (&acc)[2][2][4][2], const Unit& u, int wr, int wc, int fr, int fq) const {
        const int row0 = u.pm * BM + wr * 64 + fr, col0 = u.pn * BM + wc * 32 + 8 * fq; const float* gp = gate + (size_t)(u.pm >> 4) * 12288 + col0;
        const PG8_LAS float* r = rs + (u.idx * 256 + wr * 64 + fr) * 2 + 1;
        f32x4 gv[2][2];
#pragma unroll
        for (int bj = 0; bj < 2; ++bj)
#pragma unroll
            for (int n = 0; n < 2; ++n) gv[bj][n] = *(const f32x4*)(gp + bj * HALF + n * 4) * sc;
#pragma unroll
        for (int ai = 0; ai < 2; ++ai) { f32x4 pre[4][2][2]; u32x4 praw[4][2];
#pragma unroll
            for (int m = 0; m < 4; ++m) { const size_t off = (size_t)(row0 + ai * HALF + m * 16) * 2048 + col0;
#pragma unroll
                for (int bj = 0; bj < 2; ++bj) {
                    if (XF32) { pre[m][bj][0] = *(const f32x4*)((const float*)xin + off + bj * HALF); pre[m][bj][1] = *(const f32x4*)((const float*)xin + off + bj * HALF + 4); }
                    else praw[m][bj] = *(const u32x4*)((const bf16_t*)xin + off + bj * HALF); } }
            __builtin_amdgcn_sched_barrier(0);
#pragma unroll
            for (int m = 0; m < 4; ++m) { const size_t off = (size_t)(row0 + ai * HALF + m * 16) * 2048 + col0; float rf = 1.f; if (NRM) rf = r[(ai * HALF + m * 16) * 2];
#pragma unroll
                for (int bj = 0; bj < 2; ++bj) { f32x4 x0, x1, v0, v1;
                    if (XF32) { x0 = pre[m][bj][0]; x1 = pre[m][bj][1]; }
                    else { const u32x4 w = praw[m][bj];
                        x0 = (f32x4){__builtin_bit_cast(float, w.x << 16), __builtin_bit_cast(float, w.x & 0xffff0000u), __builtin_bit_cast(float, w.y << 16), __builtin_bit_cast(float, w.y & 0xffff0000u)};
                        x1 = (f32x4){__builtin_bit_cast(float, w.z << 16), __builtin_bit_cast(float, w.z & 0xffff0000u), __builtin_bit_cast(float, w.w << 16), __builtin_bit_cast(float, w.w & 0xffff0000u)}; }
                    if (NRM) { v0 = x0 + gv[bj][0] * (acc[ai][bj][m][0] * rf); v1 = x1 + gv[bj][1] * (acc[ai][bj][m][1] * rf); }
                    else { v0 = x0 + gv[bj][0] * acc[ai][bj][m][0]; v1 = x1 + gv[bj][1] * acc[ai][bj][m][1]; }
                    u32x4 w; w.x = cvt_pk_bf16(v0[0], v0[1]); w.y = cvt_pk_bf16(v0[2], v0[3]); w.z = cvt_pk_bf16(v1[0], v1[1]); w.w = cvt_pk_bf16(v1[2], v1[3]);
                    *(u32x4*)(out + off + bj * HALF) = w; } }
            __builtin_amdgcn_sched_barrier(0); }
    }
};
struct EpiSwiGLU {
    static constexpr bool PERM = true, AFTER_DRAIN = false, HAS_MID = false;
    bf16_t* O; int ldc;
    __device__ __forceinline__ void operator()(const f32x4 (&acc)[2][2][4][2], const Unit& u, int wr, int wc, int fr, int fq) const {
        const int row0 = u.pm * BM + wr * 64 + fr, col0 = u.pn * HALF + wc * 32 + 8 * fq;
#pragma unroll
        for (int ai = 0; ai < 2; ++ai)
#pragma unroll
            for (int m = 0; m < 4; ++m) { bf16_t* rowp = O + (size_t)(row0 + ai * HALF + m * 16) * ldc + col0; float a[8];
#pragma unroll
                for (int n = 0; n < 2; ++n)
#pragma unroll
                    for (int j = 0; j < 4; ++j) { const float g = acc[ai][0][m][n][j], up = acc[ai][1][m][n][j];
                        a[n * 4 + j] = g * __builtin_amdgcn_rcpf(1.0f + __builtin_amdgcn_exp2f(-1.4426950408889634f * g)) * up; }
                u32x4 w; w.x = cvt_pk_bf16(a[0], a[1]); w.y = cvt_pk_bf16(a[2], a[3]); w.z = cvt_pk_bf16(a[4], a[5]); w.w = cvt_pk_bf16(a[6], a[7]);
                *(u32x4*)rowp = w; }
    }
};
struct EpiSwiGLU8 {
    static constexpr bool PERM = true, AFTER_DRAIN = false, HAS_MID = false;
    unsigned char* O; int ldc; float sc;
    __device__ __forceinline__ void operator()(const f32x4 (&acc)[2][2][4][2], const Unit& u, int wr, int wc, int fr, int fq) const {
        const int row0 = u.pm * BM + wr * 64 + fr, col0 = u.pn * HALF + wc * 32 + 8 * fq; const float S = 1.0f / (sc * sc);
#pragma unroll
        for (int ai = 0; ai < 2; ++ai)
#pragma unroll
            for (int m = 0; m < 4; ++m) { unsigned char* rowp = O + (size_t)(row0 + ai * HALF + m * 16) * ldc + col0; float a[8];
#pragma unroll
                for (int n = 0; n < 2; ++n)
#pragma unroll
                    for (int j = 0; j < 4; j += 2) {
                        typedef float f32x2 __attribute__((ext_vector_type(2)));
                        const f32x2 g = {acc[ai][0][m][n][j], acc[ai][0][m][n][j + 1]}, up = {acc[ai][1][m][n][j], acc[ai][1][m][n][j + 1]};
                        const f32x2 t = g * (-1.4426950408889634f * sc); f32x2 e; e.x = __builtin_amdgcn_exp2f(t.x); e.y = __builtin_amdgcn_exp2f(t.y);
                        const f32x2 d = e * S + S; f32x2 r; r.x = __builtin_amdgcn_rcpf(d.x); r.y = __builtin_amdgcn_rcpf(d.y);
                        const f32x2 o = (g * up) * r; a[n * 4 + j] = o.x; a[n * 4 + j + 1] = o.y; }
                typedef unsigned u32x2 __attribute__((ext_vector_type(2)));
                u32x2 w; w.x = pk_fp8x4(a[0], a[1], a[2], a[3]); w.y = pk_fp8x4(a[4], a[5], a[6], a[7]);
                *(u32x2*)rowp = w; }
    }
};
struct EpiBf16S {
    static constexpr bool PERM = true, AFTER_DRAIN = false, HAS_MID = false;
    bf16_t* O; int ldc; float sc;
    __device__ __forceinline__ void operator()(const f32x4 (&acc)[2][2][4][2], const Unit& u, int wr, int wc, int fr, int fq) const {
        const int row0 = u.pm * BM + wr * 64 + fr, col0 = u.pn * BM + wc * 32 + 8 * fq;
#pragma unroll
        for (int ai = 0; ai < 2; ++ai)
#pragma unroll
            for (int m = 0; m < 4; ++m) { bf16_t* rowp = O + (size_t)(row0 + ai * HALF + m * 16) * ldc + col0;
#pragma unroll
                for (int bj = 0; bj < 2; ++bj) { const f32x4 v0 = acc[ai][bj][m][0] * sc, v1 = acc[ai][bj][m][1] * sc;
                    u32x4 w; w.x = cvt_pk_bf16(v0[0], v0[1]); w.y = cvt_pk_bf16(v0[2], v0[3]); w.z = cvt_pk_bf16(v1[0], v1[1]); w.w = cvt_pk_bf16(v1[2], v1[3]);
                    *(u32x4*)(rowp + bj * HALF) = w; } }
    }
};
struct EpiF32 {
    static constexpr bool PERM = false, AFTER_DRAIN = false, HAS_MID = false;
    float* out; float sc;
    __device__ __forceinline__ void operator()(const f32x4 (&acc)[2][2][4][2], const Unit& u, int wr, int wc, int fr, int fq) const {
        const int row0 = u.pm * BM + wr * 64 + fr, col0 = u.pn * BM + wc * 32 + 4 * fq;
#pragma unroll
        for (int ai = 0; ai < 2; ++ai)
#pragma unroll
            for (int m = 0; m < 4; ++m) { const size_t off = (size_t)(row0 + ai * HALF + m * 16) * 2048 + col0;
#pragma unroll
                for (int bj = 0; bj < 2; ++bj)
#pragma unroll
                    for (int n = 0; n < 2; ++n) *(f32x4*)(out + off + bj * HALF + n * 16) = acc[ai][bj][m][n] * sc; }
    }
};
struct MoeOrder {
    int nM, nN, nwg, G, c, wgm; const PG8_LAS int* tile_e;
    __device__ void init(int nM_, int N, int G_, int c_, const PG8_LAS int* te, int wgm_ = WGM) { nM = nM_; nN = N / BM; nwg = nM * nN; G = G_; c = c_; tile_e = te; wgm = wgm_; }
    __device__ bool next(int i, Unit& u) const {
        const long L = (long)i * G + c; if (L >= nwg) return false;
        int wgid = (int)L; { const int q = nwg / NXCD, r = nwg % NXCD, xcd = wgid % NXCD, off = wgid / NXCD; wgid = (xcd < r ? xcd * (q + 1) : r * (q + 1) + (xcd - r) * q) + off; }
        const int nig = wgm * nN, gid = wgid / nig, fm = gid * wgm, gsz = (nM - fm) < wgm ? (nM - fm) : wgm;
        u.pm = fm + ((wgid % nig) % gsz); u.pn = (wgid % nig) / gsz; u.be = __builtin_amdgcn_readfirstlane(tile_e[u.pm]); u.idx = i; u.koff = 0u; return true;
    }
    __device__ __forceinline__ void a_ready(const Unit&) const {}
    __device__ __forceinline__ void done(const Unit&) const {}
};

struct MoeSplitOrder {
    int nF, nR, S, G, c; unsigned slice_bytes; const PG8_LAS int* tile_e;
    __device__ bool next(int i, Unit& u) const {
        const int L = i * G + c; if (L >= nR * 8 * S) return false;
        const int t = L >> 3, ks = t / nR; u.pn = L & 7; u.pm = nF + (t - ks * nR); u.be = __builtin_amdgcn_readfirstlane(tile_e[u.pm]); u.idx = ks; u.koff = (unsigned)ks * slice_bytes; return true;
    }
    __device__ __forceinline__ void a_ready(const Unit&) const {}
    __device__ __forceinline__ void done(const Unit&) const {}
};
struct EpiF32P {
    static constexpr bool PERM = false, AFTER_DRAIN = false, HAS_MID = false;
    float* out; int nF, nR; float sc;
    __device__ __forceinline__ void operator()(const f32x4 (&acc)[2][2][4][2], const Unit& u, int wr, int wc, int fr, int fq) const {
        const int row0 = (u.idx * nR + (u.pm - nF)) * BM + wr * 64 + fr, col0 = u.pn * BM + wc * 32 + 4 * fq;
#pragma unroll
        for (int ai = 0; ai < 2; ++ai)
#pragma unroll
            for (int m = 0; m < 4; ++m) { const size_t off = (size_t)(row0 + ai * HALF + m * 16) * 2048 + col0;
#pragma unroll
                for (int bj = 0; bj < 2; ++bj)
#pragma unroll
                    for (int n = 0; n < 2; ++n) *(f32x4*)(out + off + bj * HALF + n * 16) = acc[ai][bj][m][n] * sc; }
    }
};
template <class Epi, class Sched, bool ALIGN_EPI = false, bool SP2 = false, bool FP8 = false>
__device__ __forceinline__ void gemm_phase(PG8_LAS unsigned char* lds, const Gemm g, const Sched& S, const Epi& E) {
    int tid_ = threadIdx.x; asm volatile("" : "+v"(tid_));
    const int tid = tid_, wid = __builtin_amdgcn_readfirstlane(tid >> 6), lane = tid & 63, wr = wid >> 2, wc = wid & 3, fr = lane & 15, fq = lane >> 4;
    const int K = g.K, nt = g.nt ? g.nt : K / BK;
    unsigned voffA[2], voffB[2];
#pragma unroll
    for (int i = 0; i < 2; ++i) { int R, C; stage_rc(tid * 16 + i * 8192, R, C); const int Rb = Epi::PERM ? ((R & ~31) + perm32(R & 31)) : R;
        voffA[i] = (unsigned)(R * K + C) * 2u; voffB[i] = (unsigned)(Rb * K + C) * 2u; }
    const size_t kstep = (size_t)(BK * 2);
    const size_t hstep = (size_t)HALF * K * 2;
    const size_t tstep = 2 * hstep;
    const unsigned ldsw = (unsigned)wid * 1024u;
    const int aoff = lds_byte(wr * 64 + fr, fq * 8), boff = lds_byte(wc * 32 + fr, fq * 8);
#define PG8_SA(b, h) (((b) * 2 + (h)) * HTB)
#define PG8_SB(b, h) ((4 + (b) * 2 + (h)) * HTB)
#define PG8_STAGE(bufoff, gbase, voff) do { _Pragma("unroll") for (int _i = 0; _i < 2; ++_i) \
        __builtin_amdgcn_global_load_lds((const unsigned*)((const char*)(gbase) + (voff)[_i]), (PG8_LAS unsigned*)(lds + (bufoff) + ldsw + _i * 8192), 16, 0, 0); } while (0)
#define PG8_LDA(dst, b, h) do { _Pragma("unroll") for (int m = 0; m < 4; ++m) _Pragma("unroll") for (int k = 0; k < 2; ++k) dst[m][k] = *(const PG8_LAS bf16x8*)(lds + PG8_SA(b, h) + aoff + m * 2048 + k * 1024); } while (0)
#define PG8_LDB(dst, b, h) do { _Pragma("unroll") for (int n = 0; n < 2; ++n) _Pragma("unroll") for (int k = 0; k < 2; ++k) dst[n][k] = *(const PG8_LAS bf16x8*)(lds + PG8_SB(b, h) + boff + n * 2048 + k * 1024); } while (0)
#define PG8_MMA(ai, bj, At, Bt) do { __builtin_amdgcn_s_setprio(1); _Pragma("unroll") for (int m = 0; m < 4; ++m) _Pragma("unroll") for (int n = 0; n < 2; ++n) { \
        if constexpr (FP8) acc[ai][bj][m][n] = mfma_fp8_128(Bt[n][0], Bt[n][1], At[m][0], At[m][1], acc[ai][bj][m][n]); \
        else { _Pragma("unroll") for (int k = 0; k < 2; ++k) acc[ai][bj][m][n] = __builtin_amdgcn_mfma_f32_16x16x32_bf16(Bt[n][k], At[m][k], acc[ai][bj][m][n], 0, 0, 0); } } \
        __builtin_amdgcn_s_setprio(0); } while (0)
#define PG8_WAIT_V(n) asm volatile("s_waitcnt vmcnt(" #n ")" ::: "memory")
#define PG8_WAIT_L(n) asm volatile("s_waitcnt lgkmcnt(" #n ")" ::: "memory")
#define PG8_BAR __builtin_amdgcn_s_barrier()
#define PG8_SCHED __builtin_amdgcn_sched_barrier(0)
    Unit cur, nxt; int ui = 0;
    if (!S.next(0, cur)) return;
    f32x4 acc[2][2][4][2];
#pragma unroll
    for (int a = 0; a < 2; ++a)
#pragma unroll
        for (int b = 0; b < 2; ++b)
#pragma unroll
            for (int m = 0; m < 4; ++m)
#pragma unroll
                for (int n = 0; n < 2; ++n) acc[a][b][m][n] = (f32x4){0.f, 0.f, 0.f, 0.f};
    bf16x8 At[4][2], B0[2][2], B1[2][2];
    const char* cA = (const char*)g.A + (size_t)cur.pm * tstep + cur.koff; const char* cB = (const char*)g.Bt + (size_t)cur.be * g.bstride + (size_t)cur.pn * tstep + cur.koff;
    S.a_ready(cur);
    if constexpr (SP2) {
        PG8_STAGE(PG8_SB(0, 0), cB, voffB); PG8_STAGE(PG8_SB(0, 1), cB + hstep, voffB); PG8_STAGE(PG8_SA(0, 0), cA, voffA); PG8_STAGE(PG8_SA(0, 1), cA + hstep, voffA);
        if (wr == 1) PG8_BAR;
        PG8_WAIT_V(2); PG8_BAR;
        PG8_STAGE(PG8_SB(1, 0), cB + kstep, voffB); PG8_STAGE(PG8_SA(1, 0), cA + kstep, voffA); PG8_STAGE(PG8_SB(1, 1), cB + hstep + kstep, voffB);
        PG8_WAIT_V(6); PG8_BAR;
    } else {
        PG8_STAGE(PG8_SB(0, 0), cB, voffB); PG8_STAGE(PG8_SA(0, 0), cA, voffA); PG8_STAGE(PG8_SB(0, 1), cB + hstep, voffB); PG8_STAGE(PG8_SA(0, 1), cA + hstep, voffA);
        if (wr == 1) PG8_BAR;
        PG8_WAIT_V(4); PG8_BAR;
        PG8_STAGE(PG8_SB(1, 0), cB + kstep, voffB); PG8_STAGE(PG8_SA(1, 0), cA + kstep, voffA); PG8_STAGE(PG8_SB(1, 1), cB + hstep + kstep, voffB);
        PG8_WAIT_V(6); PG8_BAR;
    }
    for (;;) {
        const bool has_next = S.next(ui + 1, nxt);
        const char* nA = has_next ? (const char*)g.A + (size_t)nxt.pm * tstep + nxt.koff : cA; const char* nB = has_next ? (const char*)g.Bt + (size_t)nxt.be * g.bstride + (size_t)nxt.pn * tstep + nxt.koff : cB;
        for (int t = 0; t < nt; t += 2) {
            if constexpr (Epi::HAS_MID) { if (t == nt / 2) E.mid(acc, cur, wr, wc, fr, fq); }
            const bool last = (t == nt - 2);
            const char* a1 = cA + (size_t)(t + 1) * kstep;
            const char* a2 = last ? nA : cA + (size_t)(t + 2) * kstep; const char* b2 = last ? nB : cB + (size_t)(t + 2) * kstep;
            const char* a3 = a2 + kstep; const char* b3 = b2 + kstep;
            if (last && has_next) S.a_ready(nxt);
            if constexpr (SP2) {
            PG8_LDB(B0, 0, 0); PG8_LDB(B1, 0, 1); PG8_SCHED; PG8_LDA(At, 0, 0); PG8_STAGE(PG8_SA(1, 1), a1 + hstep, voffA);
            PG8_WAIT_V(8); PG8_WAIT_L(0); PG8_BAR; PG8_MMA(0, 0, At, B0); PG8_MMA(0, 1, At, B1); PG8_BAR; PG8_SCHED;
            PG8_LDA(At, 0, 1); PG8_STAGE(PG8_SB(0, 0), b2, voffB); PG8_STAGE(PG8_SB(0, 1), b2 + hstep, voffB); PG8_STAGE(PG8_SA(0, 0), a2, voffA);
            PG8_WAIT_V(8); PG8_WAIT_L(0); PG8_BAR; PG8_MMA(1, 0, At, B0); PG8_MMA(1, 1, At, B1); PG8_BAR; PG8_SCHED;
            PG8_LDB(B0, 1, 0); PG8_LDB(B1, 1, 1); PG8_SCHED; PG8_LDA(At, 1, 0); PG8_STAGE(PG8_SA(0, 1), a2 + hstep, voffA);
            PG8_WAIT_V(8); PG8_WAIT_L(0); PG8_BAR; PG8_MMA(0, 0, At, B0); PG8_MMA(0, 1, At, B1); PG8_BAR; PG8_SCHED;
            PG8_LDA(At, 1, 1); PG8_STAGE(PG8_SB(1, 0), b3, voffB); PG8_STAGE(PG8_SB(1, 1), b3 + hstep, voffB); PG8_STAGE(PG8_SA(1, 0), a3, voffA);
            PG8_WAIT_V(8); PG8_WAIT_L(0); PG8_BAR; PG8_MMA(1, 0, At, B0); PG8_MMA(1, 1, At, B1); PG8_BAR; PG8_SCHED;
            } else {
            PG8_LDB(B0, 0, 0); PG8_SCHED; PG8_LDA(At, 0, 0); PG8_STAGE(PG8_SA(1, 1), a1 + hstep, voffA);
            PG8_WAIT_L(8); PG8_BAR; PG8_WAIT_L(0); PG8_MMA(0, 0, At, B0); PG8_BAR; PG8_SCHED;
            PG8_LDB(B1, 0, 1); PG8_STAGE(PG8_SB(0, 0), b2, voffB);
            PG8_BAR; PG8_WAIT_L(0); PG8_MMA(0, 1, At, B1); PG8_BAR;
            PG8_LDA(At, 0, 1); PG8_STAGE(PG8_SA(0, 0), a2, voffA);
            PG8_BAR; PG8_WAIT_L(0); PG8_MMA(1, 0, At, B0); PG8_BAR; PG8_SCHED;
            PG8_STAGE(PG8_SB(0, 1), b2 + hstep, voffB);
            PG8_WAIT_V(6); PG8_BAR; PG8_MMA(1, 1, At, B1); PG8_BAR;
            PG8_LDB(B0, 1, 0); PG8_SCHED; PG8_LDA(At, 1, 0); PG8_STAGE(PG8_SA(0, 1), a2 + hstep, voffA);
            PG8_WAIT_L(8); PG8_BAR; PG8_WAIT_L(0); PG8_MMA(0, 0, At, B0); PG8_BAR; PG8_SCHED;
            PG8_LDB(B1, 1, 1); PG8_STAGE(PG8_SB(1, 0), b3, voffB);
            PG8_BAR; PG8_WAIT_L(0); PG8_MMA(0, 1, At, B1); PG8_BAR;
            PG8_LDA(At, 1, 1); PG8_STAGE(PG8_SA(1, 0), a3, voffA);
            PG8_BAR; PG8_WAIT_L(0); PG8_MMA(1, 0, At, B0); PG8_BAR; PG8_SCHED;
            PG8_STAGE(PG8_SB(1, 1), b3 + hstep, voffB);
            PG8_WAIT_V(6); PG8_BAR; PG8_MMA(1, 1, At, B1); PG8_BAR;
            }
        }
        if constexpr (ALIGN_EPI) { if (wr == 0) PG8_BAR; }
        if constexpr (FP8) {
            asm volatile("s_nop 15\n\ts_nop 15" : "+v"(acc[0][0][0][0]), "+v"(acc[0][0][0][1]), "+v"(acc[0][0][1][0]), "+v"(acc[0][0][1][1]), "+v"(acc[0][0][2][0]), "+v"(acc[0][0][2][1]), "+v"(acc[0][0][3][0]), "+v"(acc[0][0][3][1]));
            asm volatile("" : "+v"(acc[0][1][0][0]), "+v"(acc[0][1][0][1]), "+v"(acc[0][1][1][0]), "+v"(acc[0][1][1][1]), "+v"(acc[0][1][2][0]), "+v"(acc[0][1][2][1]), "+v"(acc[0][1][3][0]), "+v"(acc[0][1][3][1]));
            asm volatile("" : "+v"(acc[1][0][0][0]), "+v"(acc[1][0][0][1]), "+v"(acc[1][0][1][0]), "+v"(acc[1][0][1][1]), "+v"(acc[1][0][2][0]), "+v"(acc[1][0][2][1]), "+v"(acc[1][0][3][0]), "+v"(acc[1][0][3][1]));
            asm volatile("" : "+v"(acc[1][1][0][0]), "+v"(acc[1][1][0][1]), "+v"(acc[1][1][1][0]), "+v"(acc[1][1][1][1]), "+v"(acc[1][1][2][0]), "+v"(acc[1][1][2][1]), "+v"(acc[1][1][3][0]), "+v"(acc[1][1][3][1]));
        }
        if constexpr (!Epi::AFTER_DRAIN) { E(acc, cur, wr, wc, fr, fq); S.done(cur); }
        if (!has_next) break;
#pragma unroll
        for (int a = 0; a < 2; ++a)
#pragma unroll
            for (int b = 0; b < 2; ++b)
#pragma unroll
                for (int m = 0; m < 4; ++m)
#pragma unroll
                    for (int n = 0; n < 2; ++n) acc[a][b][m][n] = (f32x4){0.f, 0.f, 0.f, 0.f};
        cur = nxt; cA = nA; cB = nB; ++ui;
        if constexpr (ALIGN_EPI) { if (wr == 1) PG8_BAR; }
    }
    PG8_WAIT_V(0);
    if constexpr (!ALIGN_EPI) { if (wr == 0) PG8_BAR; }
    PG8_BAR;
    if constexpr (Epi::AFTER_DRAIN) { E.fused(acc, cur, wr, wc, fr, fq, lds, wid, lane); S.done(cur); }
#undef PG8_SA
#undef PG8_SB
#undef PG8_STAGE
#undef PG8_LDA
#undef PG8_LDB
#undef PG8_MMA
#undef PG8_WAIT_V
#undef PG8_WAIT_L
#undef PG8_BAR
#undef PG8_SCHED
}
}

namespace att {
typedef unsigned short bf16;
typedef short bf16x8 __attribute__((ext_vector_type(8)));
typedef short s16x4 __attribute__((ext_vector_type(4)));
typedef float f32x16 __attribute__((ext_vector_type(16)));
typedef float f32x4 __attribute__((ext_vector_type(4)));
typedef unsigned u32x4 __attribute__((ext_vector_type(4)));
typedef unsigned u32x2 __attribute__((ext_vector_type(2)));
constexpr int D = 128, NW = 8, QBLK = 32, KVBLK = 64, QB = NW * QBLK;
constexpr int PQ = 6144, PO = 2048;
constexpr int SHM_V = KVBLK * D * 2, SHM_K = KVBLK * D * 2;
constexpr int L_V = 0, L_K = 2 * SHM_V, L_WS = L_K + 2 * SHM_K, L_BIAS = L_WS + NW * 64 * 4, L_KM = L_BIAS + 512, L_Q = L_KM + 8192, L_FB = L_Q + NW * 8192, L_END = L_FB + 4096 * 4;
constexpr float SCALE = 0.08838834764831845f, THR = 8.f;
#define KSWZ(row, colB) ((row) * 256 + ((colB) ^ (((row) & 7) << 4)))
#define SBAR() __builtin_amdgcn_sched_barrier(0)
#ifndef ATT_QREG_FOX
#define ATT_QREG_FOX 1
#endif
#define QREG(MODE) ((MODE) == 1 && ATT_QREG_FOX)
#define AL __attribute__((address_space(3)))
__device__ __forceinline__ int v_st(int k, int c) { const int kk = (k & ~0xC) | ((k & 4) << 1) | ((k & 8) >> 1); return ((kk >> 3) * 4 + (c >> 5)) * 512 + ((kk & 7) * 32 + (c & 31)) * 2; }
__device__ __forceinline__ int v_rd_base(int lane) { return ((lane & 3) << 3) | (((lane >> 2) & 3) << 6) | (((lane >> 4) & 1) << 5) | (((lane >> 5) & 1) << 8); }
constexpr int v_rd_off(int d0, int ks, int half) { return d0 * 512 + ks * 4096 + half * 2048; }
__device__ __forceinline__ int crow(int r, int hi) { return (r & 3) + 8 * (r >> 2) + 4 * hi; }
__device__ __forceinline__ unsigned cvtpk(float lo, float hi) { unsigned r; asm volatile("v_cvt_pk_bf16_f32 %0, %1, %2" : "=v"(r) : "v"(lo), "v"(hi)); return r; }
__device__ __forceinline__ bf16x8 ld8(__amdgpu_buffer_rsrc_t rs, unsigned voff, unsigned soff) { const u32x4 w = __builtin_amdgcn_raw_buffer_load_b128(rs, (int)voff, (int)soff, 0); return __builtin_bit_cast(bf16x8, w); }
__device__ __forceinline__ void glds16(const void* gsrc, unsigned lds_dst) { unsigned keep;
    asm volatile("s_mov_b32 %0, m0\n\ts_mov_b32 m0, %2\n\ts_nop 0\n\tglobal_load_lds_dwordx4 %1, off\n\ts_mov_b32 m0, %0" : "=&s"(keep) : "v"(gsrc), "s"(lds_dst) : "memory"); }
__device__ __forceinline__ void mask_tile(f32x16& p0, f32x16& p1, int dq) {
    const float NEG = -__builtin_inff();
#pragma unroll
    for (int r = 0; r < 16; ++r) { const int c = (r & 3) + 8 * (r >> 2); if (dq - c < 0) p0[r] = NEG; if (dq - c - 32 < 0) p1[r] = NEG; }
}
__device__ __forceinline__ void partialSM(f32x16& p0, f32x16& p1, float& m_reg, float& mn, float& alpha) {
    float pmax = p0[0]; for (int r = 1; r < 16; ++r) pmax = fmaxf(pmax, p0[r]); for (int r = 0; r < 16; ++r) pmax = fmaxf(pmax, p1[r]);
    { auto rr = __builtin_amdgcn_permlane32_swap(__float_as_uint(pmax), __float_as_uint(pmax), false, false); pmax = fmaxf(__uint_as_float(rr[0]), __uint_as_float(rr[1])); }
    constexpr float C2 = 1.4426950408889634f * SCALE;
    if (__builtin_expect(__all((pmax - m_reg) * SCALE <= THR), 1)) { mn = m_reg; alpha = 1.f; }
    else { mn = fmaxf(m_reg, pmax); alpha = __builtin_amdgcn_exp2f((m_reg - mn) * C2); m_reg = mn; }
    const float mnL = -mn * C2;
    for (int r = 0; r < 16; ++r) p0[r] = fmaf(p0[r], C2, mnL); for (int r = 0; r < 16; ++r) p1[r] = fmaf(p1[r], C2, mnL);
    for (int r = 0; r < 16; ++r) p0[r] = __builtin_amdgcn_exp2f(p0[r]);
}
__device__ __forceinline__ void finishSM(f32x16& p0, f32x16& p1, float alpha, float& l_reg, bf16x8& pa0, bf16x8& pa1, bf16x8& pa2, bf16x8& pa3) {
    for (int r = 0; r < 16; ++r) p1[r] = __builtin_amdgcn_exp2f(p1[r]);
    float ps = 0; for (int r = 0; r < 16; ++r) ps += p0[r]; for (int r = 0; r < 16; ++r) ps += p1[r];
    { auto rr = __builtin_amdgcn_permlane32_swap(__float_as_uint(ps), __float_as_uint(ps), false, false); ps = __uint_as_float(rr[0]) + __uint_as_float(rr[1]); }
    l_reg = l_reg * alpha + ps;
#define PK4(P, B_, OUT) do { unsigned a0 = cvtpk(P[B_+0], P[B_+1]), a1 = cvtpk(P[B_+2], P[B_+3]);                          \
        unsigned b0 = cvtpk(P[B_+4], P[B_+5]), b1 = cvtpk(P[B_+6], P[B_+7]);                                             \
        auto r0 = __builtin_amdgcn_permlane32_swap(a0, b0, false, false); auto r1 = __builtin_amdgcn_permlane32_swap(a1, b1, false, false); \
        u32x4 w = {r0[0], r1[0], r0[1], r1[1]}; OUT = *reinterpret_cast<bf16x8*>(&w); } while (0)
    PK4(p0, 0, pa0); PK4(p0, 8, pa1); PK4(p1, 0, pa2); PK4(p1, 8, pa3);
#undef PK4
}
template <int KB, int MODE>
__device__ __forceinline__ void qkt(f32x16& p0, f32x16& p1, const AL char* lds, int r32, int hi, const AL char* qf, const bf16x8* qr, float rb, int k0) {
    if constexpr (MODE == 1) {
        const AL f32x4* f = (const AL f32x4*)(lds + L_FB + (k0 + 4 * hi) * 4);
        const f32x4 a0 = f[0], a1 = f[2], a2 = f[4], a3 = f[6], b0 = f[8], b1 = f[10], b2 = f[12], b3 = f[14];
        typedef float f32x8 __attribute__((ext_vector_type(8)));
        const f32x8 a01 = __builtin_shufflevector(a0, a1, 0, 1, 2, 3, 4, 5, 6, 7), a23 = __builtin_shufflevector(a2, a3, 0, 1, 2, 3, 4, 5, 6, 7);
        const f32x8 b01 = __builtin_shufflevector(b0, b1, 0, 1, 2, 3, 4, 5, 6, 7), b23 = __builtin_shufflevector(b2, b3, 0, 1, 2, 3, 4, 5, 6, 7);
        p0 = __builtin_shufflevector(a01, a23, 0, 1, 2, 3, 4, 5, 6, 7, 8, 9, 10, 11, 12, 13, 14, 15);
        p1 = __builtin_shufflevector(b01, b23, 0, 1, 2, 3, 4, 5, 6, 7, 8, 9, 10, 11, 12, 13, 14, 15); }
    else {
#pragma unroll
        for (int r = 0; r < 16; ++r) { p0[r] = rb; p1[r] = rb; } }
    const AL char* K_lds = lds + L_K; const AL char* kb[4];
#pragma unroll
    for (int dd = 0; dd < 4; ++dd) kb[dd] = K_lds + KB * SHM_K + KSWZ(r32, (dd * 16 + hi * 8) * 2);
#pragma unroll
    for (int d0 = 0; d0 < 8; ++d0) { const AL char* a = kb[d0 & 3] + (d0 >> 2) * 128;
        bf16x8 b0 = *(const AL bf16x8*)(a);
        bf16x8 b1 = *(const AL bf16x8*)(a + 32 * 256);
        const bf16x8 q = QREG(MODE) ? qr[d0] : *(const AL bf16x8*)(qf + d0 * 1024);
        p0 = __builtin_amdgcn_mfma_f32_32x32x16_bf16(b0, q, p0, 0, 0, 0);
        p1 = __builtin_amdgcn_mfma_f32_32x32x16_bf16(b1, q, p1, 0, 0, 0); }
}
template <int VB>
__device__ __forceinline__ void pv_tile(f32x16* o, int vb0, bf16x8 pa0, bf16x8 pa1, bf16x8 pa2, bf16x8 pa3) {
#define TRRD(dst, off) asm volatile("ds_read_b64_tr_b16 %0, %1 offset:%2" : "=&v"(dst) : "v"(vb0), "i"(off) : "memory")
#define PV_D0(d0) do { s16x4 l0, l1, l2, l3, h0, h1, h2, h3; constexpr int b_ = VB * SHM_V + v_rd_off(d0, 0, 0);   \
        TRRD(l0, b_); TRRD(h0, b_ + 2048); TRRD(l1, b_ + 4096); TRRD(h1, b_ + 6144); TRRD(l2, b_ + 8192); TRRD(h2, b_ + 10240); TRRD(l3, b_ + 12288); TRRD(h3, b_ + 14336); \
        asm volatile("s_waitcnt lgkmcnt(0)" ::: "memory"); SBAR();                                                    \
        o[d0] = __builtin_amdgcn_mfma_f32_32x32x16_bf16(pa0, (bf16x8){l0[0], l0[1], l0[2], l0[3], h0[0], h0[1], h0[2], h0[3]}, o[d0], 0, 0, 0);   \
        o[d0] = __builtin_amdgcn_mfma_f32_32x32x16_bf16(pa1, (bf16x8){l1[0], l1[1], l1[2], l1[3], h1[0], h1[1], h1[2], h1[3]}, o[d0], 0, 0, 0);   \
        o[d0] = __builtin_amdgcn_mfma_f32_32x32x16_bf16(pa2, (bf16x8){l2[0], l2[1], l2[2], l2[3], h2[0], h2[1], h2[2], h2[3]}, o[d0], 0, 0, 0);   \
        o[d0] = __builtin_amdgcn_mfma_f32_32x32x16_bf16(pa3, (bf16x8){l3[0], l3[1], l3[2], l3[3], h3[0], h3[1], h3[2], h3[3]}, o[d0], 0, 0, 0); } while (0)
    PV_D0(0); PV_D0(1); PV_D0(2); PV_D0(3);
#undef PV_D0
#undef TRRD
}
struct Ref { unsigned Q, K, V, O; int qb; int row0, head16; };
struct Seam { bf16x8 st_v0, st_v1, st_k0, st_k1; };
#define VMW() asm volatile("s_waitcnt vmcnt(0)" ::: "memory")
#define VMWN(n) asm volatile("s_waitcnt vmcnt(%0)" :: "i"(n) : "memory")
#define SLOAD_H(R, k0) do { const unsigned kt_ = (R).K + (unsigned)(k0) * (2u * PQ), vt_ = (R).V + (unsigned)(k0) * (2u * PQ);                                                                \
                            S.st_v0 = ld8(rsq, vo0, vt_); S.st_v1 = ld8(rsq, vo1, vt_); S.st_k0 = ld8(rsq, vo0, kt_); S.st_k1 = ld8(rsq, vo1, kt_); } while (0)
#define SWRITE_HK(bf) do { *(AL bf16x8*)(K_lds + (bf) * SHM_K + kws) = S.st_k0; *(AL bf16x8*)(K_lds + (bf) * SHM_K + kws + 32 * 256) = S.st_k1; } while (0)
#define SWRITE_HV(bf) do { *(AL bf16x8*)(V_lds + (bf) * SHM_V + vst0) = S.st_v0; *(AL bf16x8*)(V_lds + (bf) * SHM_V + vst1) = S.st_v1; } while (0)
#define SWRITE_H(bf) do { SWRITE_HV(bf); SWRITE_HK(bf); } while (0)
#define ATT_IDS int tid_ = threadIdx.x; asm volatile("" : "+v"(tid_)); const int tid = tid_, wid = __builtin_amdgcn_readfirstlane(tid >> 6), lane = tid & 63, r32 = lane & 31, hi = lane >> 5;   \
    const int sr = tid >> 4, sc = (tid & 15) * 8, kws = KSWZ(sr, sc * 2);                                                                           \
    const unsigned vo0 = 2u * (unsigned)(sr * PQ + sc), vo1 = vo0 + 64u * PQ, voq = 2u * (unsigned)((wid * QBLK + r32) * PQ + hi * 8); (void)vo0; (void)vo1; (void)voq;     \
    AL char* V_lds = lds + L_V; AL char* K_lds = lds + L_K; (void)V_lds; (void)hi; (void)r32;                                                \
    const AL char* qf = lds + L_Q + wid * 8192 + lane * 16; const unsigned qdma = (unsigned)(uintptr_t)(lds + L_Q) + (unsigned)wid * 8192u; (void)qf; (void)qdma
template <int MODE>
__device__ __forceinline__ void prime(const Ref& cur, AL char* lds, Seam& S, __amdgpu_buffer_rsrc_t rsq, const char* qkvb) {
    ATT_IDS;
#pragma unroll
    for (int d0 = 0; d0 < 8; ++d0) glds16(qkvb + cur.Q + voq + d0 * 32, (unsigned)__builtin_amdgcn_readfirstlane(qdma + d0 * 1024));
    SLOAD_H(cur, 0); VMW(); SWRITE_HK(0);
    __syncthreads();
}
template <int MODE>
__device__ __forceinline__ void block(const Ref& cur, const Ref& nxt, AL char* lds, Seam& S, unsigned selmask, __amdgpu_buffer_rsrc_t rsq, __amdgpu_buffer_rsrc_t rso, const char* qkvb, float* ssq) {
    ATT_IDS;
    const int NT = 4 * (cur.qb + 1);
    const int qlo = cur.qb * QB + wid * QBLK, qm = qlo + r32 - 4 * hi;
    AL float* ws = (AL float*)(lds + L_WS) + wid * 64; AL float* li_l = ws; AL float* al_l = ws + 32;
    float m_reg = -1e30f, l_reg = 0; f32x16 o[4] = {};
    const int vst0 = v_st(sr, sc), vst1 = v_st(32 + sr, sc);
    const int vb0 = (int)(unsigned)(uintptr_t)V_lds + v_rd_base(lane);
    const float NEGI = -__builtin_inff();
#define RESC(a) do { if (__any((a) < 1.f)) { if (hi == 0) al_l[r32] = (a); asm volatile("s_waitcnt lgkmcnt(0)" ::: "memory");              \
                     for (int d_ = 0; d_ < 4; ++d_) for (int r = 0; r < 16; ++r) o[d_][r] *= al_l[crow(r, hi)]; } } while (0)
#define KBASE(t) ((t) * KVBLK)
#define RB(t) ((MODE == 0) ? (((selmask >> ((t) >> 2)) & 1u) ? 0.f : NEGI) : 0.f)
#define MASKT(P0_, P1_, t) do { const int kb_ = KBASE(t); if (kb_ + KVBLK - 1 > qlo) mask_tile(P0_, P1_, qm - kb_); } while (0)
#define SEAM_K0() do { VMWN(8); SWRITE_HK(0); SBAR(); } while (0)
    f32x16 pA0, pA1, pB0, pB1; float mnA, mnB, alA, alB; bf16x8 pa0, pa1, pa2, pa3;
    bf16x8 qr[8];
    if constexpr (QREG(MODE)) {
#pragma unroll
        for (int d0 = 0; d0 < 8; ++d0) qr[d0] = *(const AL bf16x8*)(qf + d0 * 1024); }
    SWRITE_HV(0); SBAR();
    SLOAD_H(cur, KBASE(1));
    SBAR(); qkt<0, MODE>(pA0, pA1, lds, r32, hi, qf, qr, RB(0), 0);
    MASKT(pA0, pA1, 0); partialSM(pA0, pA1, m_reg, mnA, alA);
    VMW(); SWRITE_H(1);
    __syncthreads();
#define HALF_STEP(PX0, PX1, mnX, alX, PY0, PY1, alY, t, KB, VB, SB) do {                                                      \
        SBAR(); qkt<KB, MODE>(PX0, PX1, lds, r32, hi, qf, qr, RB(t), KBASE(t));                                                          \
        finishSM(PY0, PY1, alY, l_reg, pa0, pa1, pa2, pa3); SBAR();                                                           \
        if ((t) + 1 < NT) { SLOAD_H(cur, KBASE((t) + 1)); SBAR(); }                                                           \
        pv_tile<VB>(o, vb0, pa0, pa1, pa2, pa3); MASKT(PX0, PX1, (t)); partialSM(PX0, PX1, m_reg, mnX, alX);                  \
        __syncthreads();                                                                                                      \
        if ((t) + 1 < NT) { VMW(); SWRITE_H(SB); }                                                                            \
        RESC(alX); __syncthreads(); } while (0)
    for (int t = 1; t + 1 < NT; t += 2) {
        HALF_STEP(pB0, pB1, mnB, alB, pA0, pA1, alA, t, 1, 0, 0);
        HALF_STEP(pA0, pA1, mnA, alA, pB0, pB1, alB, t + 1, 0, 1, 1);
    }
    SBAR(); qkt<1, MODE>(pB0, pB1, lds, r32, hi, qf, qr, RB(NT - 1), KBASE(NT - 1)); asm volatile("s_waitcnt lgkmcnt(0)" ::: "memory"); SBAR();
    SLOAD_H(nxt, 0); SBAR();
#pragma unroll
    for (int d0 = 0; d0 < 8; ++d0) glds16(qkvb + nxt.Q + voq + d0 * 32, (unsigned)__builtin_amdgcn_readfirstlane(qdma + d0 * 1024));
    SBAR();
    finishSM(pA0, pA1, alA, l_reg, pa0, pa1, pa2, pa3); SBAR();
    pv_tile<0>(o, vb0, pa0, pa1, pa2, pa3);
    MASKT(pB0, pB1, NT - 1); partialSM(pB0, pB1, m_reg, mnB, alB); __syncthreads(); RESC(alB);
    finishSM(pB0, pB1, alB, l_reg, pa0, pa1, pa2, pa3); SBAR(); pv_tile<1>(o, vb0, pa0, pa1, pa2, pa3);
    SBAR(); SEAM_K0();
    if (hi == 0) li_l[r32] = l_reg; asm volatile("s_waitcnt lgkmcnt(0)" ::: "memory");
    float rli[16];
#pragma unroll
    for (int r = 0; r < 16; ++r) rli[r] = __builtin_amdgcn_rcpf(li_l[crow(r, hi)]);
    const unsigned vofo = 2u * (unsigned)(hi * 4 * PO + r32);
    float sq[16];
#pragma unroll
    for (int r = 0; r < 16; ++r) { const unsigned Or = cur.O + (unsigned)(wid * QBLK + (r & 3) + 8 * (r >> 2)) * (2u * PO);
        float s2 = 0.f;
#pragma unroll
        for (int d0 = 0; d0 < 4; ++d0) { const float v = o[d0][r] * rli[r]; s2 += v * v;
            const float vn = __shfl_xor(v, 1);
            if ((r32 & 1) == 0) __builtin_amdgcn_raw_buffer_store_b32(cvtpk(v, vn), rso, (int)(vofo + d0 * 64), (int)Or, 0); }
        sq[r] = s2; }
    {
        float a8[8], a4[4], a2[2], a1;
        const bool b4 = (r32 & 16) != 0, b3 = (r32 & 8) != 0, b2 = (r32 & 4) != 0, b1 = (r32 & 2) != 0;
#pragma unroll
        for (int i = 0; i < 8; ++i) { const float send = b4 ? sq[i] : sq[i + 8], keep = b4 ? sq[i + 8] : sq[i]; a8[i] = keep + __shfl_xor(send, 16); }
#pragma unroll
        for (int i = 0; i < 4; ++i) { const float send = b3 ? a8[i] : a8[i + 4], keep = b3 ? a8[i + 4] : a8[i]; a4[i] = keep + __shfl_xor(send, 8); }
#pragma unroll
        for (int i = 0; i < 2; ++i) { const float send = b2 ? a4[i] : a4[i + 2], keep = b2 ? a4[i + 2] : a4[i]; a2[i] = keep + __shfl_xor(send, 4); }
        { const float send = b1 ? a2[0] : a2[1], keep = b1 ? a2[1] : a2[0]; a1 = keep + __shfl_xor(send, 2); }
        a1 += __shfl_xor(a1, 1);
        const int r = r32 >> 1, rowl = wid * QBLK + (r & 3) + 8 * (r >> 2) + 4 * hi;
        if ((r32 & 1) == 0) ssq[((size_t)cur.row0 + rowl) * 16 + cur.head16] = a1;
    }
    __syncthreads();
#undef RESC
#undef KBASE
#undef RB
#undef MASKT
#undef SEAM_K0
#undef HALF_STEP
}
__device__ __forceinline__ unsigned moba_select(const AL char* qf, const AL char* lds, int qb, int r32, int hi) {
    f32x16 g = {};
    const AL char* kb[4];
#pragma unroll
    for (int dd = 0; dd < 4; ++dd) kb[dd] = lds + L_KM + KSWZ(r32, (dd * 16 + hi * 8) * 2);
#pragma unroll
    for (int d0 = 0; d0 < 8; ++d0) { const bf16x8 b0 = *(const AL bf16x8*)(kb[d0 & 3] + (d0 >> 2) * 128); g = __builtin_amdgcn_mfma_f32_32x32x16_bf16(b0, *(const AL bf16x8*)(qf + d0 * 1024), g, 0, 0, 0); }
    float gv[16];
#pragma unroll
    for (int i = 0; i < 8; ++i) { auto rr = __builtin_amdgcn_permlane32_swap(__float_as_uint(g[i]), __float_as_uint(g[i]), false, false);
        const int bl = (i & 3) + 8 * (i >> 2); gv[bl] = __uint_as_float(rr[0]); gv[bl + 4] = __uint_as_float(rr[1]); }
    unsigned mask = 0u;
#pragma unroll
    for (int p = 0; p < 3; ++p) { float best = -__builtin_inff(); int bi = -1;
#pragma unroll
        for (int n = 0; n < 16; ++n) { const bool c = (n < qb) && (((mask >> n) & 1u) == 0u) && (gv[n] > best); best = c ? gv[n] : best; bi = c ? n : bi; }
        if (bi >= 0) mask |= 1u << bi; }
    return mask | (1u << qb);
}
struct Tensors { const bf16* QKV; bf16* OB; const float* LOGF; const float* KSUM; float* SSQ; };
template <int MODE>
__device__ __forceinline__ Ref mkref(const Tensors& T, int bh, int qb) {
    const int b = bh >> 3, h = bh & 7; Ref r;
    const unsigned row0 = (unsigned)b * 4096u;
    constexpr unsigned QC = MODE == 0 ? 0 : 3072, KC = MODE == 0 ? 1024 : 4096, VC = MODE == 0 ? 2048 : 5120, OC = MODE == 0 ? 0 : 1024;
    r.Q = 2u * ((row0 + (unsigned)qb * QB) * PQ + QC + h * D); r.K = 2u * (row0 * PQ + KC + h * D); r.V = 2u * (row0 * PQ + VC + h * D);
    r.O = 2u * ((row0 + (unsigned)qb * QB) * PO + OC + h * D); r.qb = qb; r.row0 = (int)(row0 + (unsigned)qb * QB); r.head16 = (MODE == 0 ? 0 : 8) + h; return r;
}
template <int MODE>
__device__ __forceinline__ void attn_phase(AL char* lds, const Tensors& T, int vcu, int G) {
    int tid_ = threadIdx.x; asm volatile("" : "+v"(tid_));
    const int tid = tid_, lane = tid & 63, r32 = lane & 31, hi = lane >> 5, wid = __builtin_amdgcn_readfirstlane(tid >> 6);
    const AL char* qf = lds + L_Q + wid * 8192 + lane * 16;
    const __amdgpu_buffer_rsrc_t rsq = __builtin_amdgcn_make_buffer_rsrc((void*)T.QKV, (short)0, (int)(16384u * PQ * 2u), 0x00020000);
    const __amdgpu_buffer_rsrc_t rso = __builtin_amdgcn_make_buffer_rsrc((void*)T.OB, (short)0, (int)(16384u * PO * 2u), 0x00020000);
    const char* qkvb = (const char*)T.QKV;
    for (int item = vcu; item < 256; item += G) {
        const int bh = item >> 3, s = item & 7;
        if constexpr (MODE == 0) {
            const int row = tid >> 5, c4 = (tid & 31) * 4;
            const f32x4 v = *(const f32x4*)((const char*)(T.KSUM + (size_t)bh * 2048) + 4u * (unsigned)(row * 128 + c4)) * (1.0f / 256.0f);
            u32x2 w; w.x = cvtpk(v[0], v[1]); w.y = cvtpk(v[2], v[3]);
            *(AL u32x2*)(lds + L_KM + KSWZ(row, c4 * 2)) = w;
        }
        if constexpr (MODE == 1) {
            AL float* fbL = (AL float*)(lds + L_FB); AL float* wsum = (AL float*)(lds + L_BIAS);
            const float* lf = T.LOGF + (size_t)bh * 4096 + wid * 512 + lane * 8;
            f32x4 a = *(const f32x4*)lf, b = *(const f32x4*)(lf + 4);
            a[1] += a[0]; a[2] += a[1]; a[3] += a[2]; b[0] += a[3]; b[1] += b[0]; b[2] += b[1]; b[3] += b[2];
            float inc = b[3];
#pragma unroll
            for (int o = 1; o < 64; o <<= 1) { const float t = __shfl_up(inc, o); if (lane >= o) inc += t; }
            if (lane == 63) wsum[wid] = inc;
            __syncthreads();
            float base = inc - b[3];
#pragma unroll
            for (int w = 0; w < 7; ++w) if (w < wid) base += wsum[w];
            constexpr float NIS = -11.313708498984761f;
            *(AL f32x4*)(fbL + wid * 512 + lane * 8) = (a + base) * NIS; *(AL f32x4*)(fbL + wid * 512 + lane * 8 + 4) = (b + base) * NIS;
        }
        Ref cur = mkref<MODE>(T, bh, s), nxt = mkref<MODE>(T, bh, 15 - s);
        Seam S; prime<MODE>(cur, lds, S, rsq, qkvb);
        for (int i = 0; i < 2; ++i) {
            unsigned selmask = 0u;
            VMW();
            if constexpr (MODE == 0) selmask = moba_select(qf, lds, cur.qb, r32, hi);
            block<MODE>(cur, nxt, lds, S, selmask, rsq, rso, qkvb, T.SSQ);
            cur = nxt;
        }
    }
}
#undef VMW
#undef VMWN
#undef SLOAD_H
#undef SWRITE_HK
#undef SWRITE_HV
#undef SWRITE_H
#undef ATT_IDS
#undef KSWZ
#undef SBAR
#undef AL
}

constexpr int NWAVES = 8;
constexpr int DM = 2048, NB = 4, SEQ = 4096, NTOK = NB * SEQ, NLAYER = 2, NHG = 8, HD = 128;
constexpr int INW = 6152, NQKV = 6144, DFF = 7168, NEXP = 8, NGU = 2 * DFF;
constexpr int MOE_ROWS = 34816;
constexpr float EPS = 1e-6f;
constexpr size_t MiB = 1u << 20;
constexpr size_t WS_CTL = 0, CTL_ZERO_BYTES = 1 * MiB;
constexpr size_t WS_MOD = 1 * MiB;
constexpr size_t WS_ROPE = 2 * MiB;
constexpr size_t WS_WFZ = 4 * MiB;
constexpr size_t WS_LOGF = 5 * MiB;
constexpr size_t WS_FBIAS = 6 * MiB;
constexpr size_t WS_KMEAN = 7 * MiB;
constexpr size_t WS_ROUTE = 8 * MiB;
constexpr size_t WS_PART = 9 * MiB;
constexpr size_t WS_WIN = 21 * MiB;
constexpr size_t WS_WO = 69 * MiB;
constexpr size_t WS_WGU = 85 * MiB;
constexpr size_t WS_WD = 589 * MiB;
constexpr size_t WS_WGU8 = WS_WGU + 56 * MiB, WS_WD8 = WS_WD + 28 * MiB;
constexpr size_t WS_XB = WS_WGU + 288 * MiB;
constexpr size_t WS_H = 841 * MiB;
constexpr size_t WS_A = 905 * MiB;
constexpr size_t WS_QKV = WS_A, WS_O = WS_A + 192 * MiB, WS_ACT = WS_A + 256 * MiB;
constexpr size_t WS_HS = WS_A, WS_ACTM = WS_A + 136 * MiB, WS_YS = WS_A + 612 * MiB;
constexpr size_t WS_YP = WS_YS + 136 * MiB;
constexpr size_t WS_END = WS_A + 884 * MiB;
static_assert((size_t)MOE_ROWS * DM * 2 <= 136 * MiB && (size_t)MOE_ROWS * DFF * 2 <= 476 * MiB && (size_t)MOE_ROWS * DM * 4 <= 272 * MiB, "MoE overlay");
static_assert((size_t)NTOK * NQKV * 2 <= 192 * MiB && (size_t)NTOK * DFF * 2 <= 224 * MiB, "layer overlay");
constexpr int CW_BAR = 4096;
constexpr size_t WS_TAB = 512 * 1024;
constexpr int RING_OFF = 0, RING_BYTES = 159744;
constexpr int LDSCTL_OFF = RING_BYTES, MISC_OFF = LDSCTL_OFF + 320;
constexpr int TILE_E_OFF = LDSCTL_OFF + 1024;
constexpr int RS_OFF = 131072, RS_UNITS = 4;
constexpr int LDS_BYTES = 163840;
static_assert(att::L_END <= RING_BYTES && TILE_E_OFF + 1024 <= LDS_BYTES && pg8::STAGE_BYTES <= RING_BYTES, "LDS map");

#define GAS __attribute__((address_space(1)))
#define LAS __attribute__((address_space(3)))
typedef unsigned short bf16;
typedef unsigned v4u __attribute__((ext_vector_type(4)));
typedef unsigned v2u __attribute__((ext_vector_type(2)));
typedef float f32x4 __attribute__((ext_vector_type(4)));
typedef GAS unsigned gu32;
#define RLX_AGENT __ATOMIC_RELAXED, __HIP_MEMORY_SCOPE_AGENT
#define LDS_WAIT() asm volatile("s_waitcnt lgkmcnt(0)" ::: "memory")
__device__ __forceinline__ unsigned f2bf(float f) { unsigned u = __builtin_bit_cast(unsigned, f); return (u + 0x7fffu + ((u >> 16) & 1u)) >> 16; }
__device__ __forceinline__ unsigned pk2(float lo, float hi) { return f2bf(lo) | (f2bf(hi) << 16); }
__device__ __forceinline__ float bf2f(unsigned short b) { return __builtin_bit_cast(float, (unsigned)b << 16); }
__device__ __forceinline__ float wave_sum(float v) {
#pragma unroll
    for (int o = 1; o < 64; o <<= 1) v += __shfl_xor(v, o);
    return v;
}
#define XB_TMO      128
#define XB_XCNT(j)  (256  + 64 * (j))
#define XB_XSUB(j)  (1280 + 64 * (j))
#define XB_XGEN(j)  (2304 + 64 * (j))
#define XB_TOP      3328
#define XB_TOPGEN   3392
#define XCD_BAR_WORDS 3456
#define XB_SPIN_CAP (1u << 18)

__device__ __forceinline__ unsigned xb_ld(unsigned* p)              { return __hip_atomic_load((GAS unsigned*)p, __ATOMIC_RELAXED, __HIP_MEMORY_SCOPE_AGENT); }
__device__ __forceinline__ unsigned xb_add(unsigned* p, unsigned v) { return __hip_atomic_fetch_add((GAS unsigned*)p, v, __ATOMIC_RELAXED, __HIP_MEMORY_SCOPE_AGENT); }
__device__ __forceinline__ unsigned xb_xcc_id() { return (unsigned)__builtin_amdgcn_s_getreg((3 << 11) | 20) & 0xFu; }
#define XB_SPIN(cond, bar) do { unsigned _sp = 0; while (cond) { __builtin_amdgcn_s_sleep(1); \
    if ((++_sp & 255u) == 0u) { if (xb_ld(&(bar)[XB_TMO])) break; if (_sp > XB_SPIN_CAP) { (void)xb_add(&(bar)[XB_TMO], 1u); break; } } } } while (0)

struct XcdBarrier {
    unsigned* bar; unsigned x;
    volatile LAS unsigned* st;
};

__device__ __forceinline__ XcdBarrier xcd_barrier_post(unsigned* bar, volatile LAS unsigned* st) {
    XcdBarrier b; b.bar = bar; b.x = xb_xcc_id(); b.st = st;
    if (threadIdx.x == 0) (void)xb_add(&bar[XB_XCNT(b.x)], 1u);
    return b;
}
__device__ __forceinline__ void xcd_barrier_complete(unsigned* bar, unsigned x, unsigned& nloc, unsigned& nx) {
    const unsigned G = gridDim.x * gridDim.y * gridDim.z;
    unsigned sum, cnt, mine, sp = 0u;
    for (;;) {
        sum = 0u; cnt = 0u; mine = 0u;
#pragma unroll
        for (unsigned j = 0; j < 16; ++j) { const unsigned c = xb_ld(&bar[XB_XCNT(j)]); sum += c; cnt += (c > 0u) ? 1u : 0u; mine = (j == x) ? c : mine; }
        if (sum == G) break;
        __builtin_amdgcn_s_sleep(1);
        if ((++sp & 255u) == 0u) { if (xb_ld(&bar[XB_TMO])) break; if (sp > XB_SPIN_CAP) { (void)xb_add(&bar[XB_TMO], 1u); break; } }
    }
    nloc = mine > 0u ? mine : 1u; nx = cnt > 0u ? cnt : 1u;
}

__device__ __attribute__((noinline)) void xcd_barrier(const XcdBarrier b) {
    asm volatile("s_waitcnt vmcnt(0)" ::: "memory");
    __syncthreads();
    if (threadIdx.x == 0) {
        unsigned* bar = b.bar;
        __builtin_amdgcn_s_waitcnt(0);
        unsigned nloc = b.st[0], nx = b.st[1];
        if (nloc == 0u) { xcd_barrier_complete(bar, b.x, nloc, nx); b.st[0] = nloc; b.st[1] = nx; }
        const unsigned old = xb_add(&bar[XB_XSUB(b.x)], 1u);
        const unsigned gen = old / nloc;
        if (old + 1u == (gen + 1u) * nloc) {
            __builtin_amdgcn_fence(__ATOMIC_RELEASE, "agent");
            asm volatile("s_waitcnt vmcnt(0)" ::: "memory");
            const unsigned og = xb_add(&bar[XB_TOP], 1u);
            const unsigned tg = og / nx;
            if (og + 1u == (tg + 1u) * nx) xb_add(&bar[XB_TOPGEN], 1u);
            else XB_SPIN(xb_ld(&bar[XB_TOPGEN]) == tg, bar);
            __builtin_amdgcn_fence(__ATOMIC_ACQUIRE, "agent");
            xb_add(&bar[XB_XGEN(b.x)], 1u);
            asm volatile("s_waitcnt vmcnt(0)" ::: "memory");
        } else {
            XB_SPIN(xb_ld(&bar[XB_XGEN(b.x)]) == gen, bar);
            __builtin_amdgcn_fence(__ATOMIC_ACQUIRE, "agent");
            asm volatile("s_waitcnt vmcnt(0)" ::: "memory");
        }
    }
    __syncthreads();
}

#ifndef DENSE_FP8
#define DENSE_FP8 1
#endif
#ifndef WGM_INPROJ
#define WGM_INPROJ 4
#endif
#ifndef WGM_WO
#define WGM_WO 4
#endif
#ifndef WGM_DUP
#define WGM_DUP 4
#endif
#ifndef WGM_DDOWN
#define WGM_DDOWN 4
#endif
#ifndef WGM_MUP
#define WGM_MUP 4
#endif
#ifndef WGM_MDOWN
#define WGM_MDOWN 4
#endif
#ifndef CONV_SPLIT
#define CONV_SPLIT 1
#endif
#ifndef CONV_CUS_A
#define CONV_CUS_A 64
#endif
#ifndef CONV_CUS_B
#define CONV_CUS_B 32
#endif
#ifndef CONV_KEEP_PCT
#define CONV_KEEP_PCT 15
#endif
#ifndef CONV_A_PCT
#define CONV_A_PCT 56
#endif
#ifndef MOE_SPLIT
#define MOE_SPLIT 1
#endif
__device__ __forceinline__ int moe_split_s(int nR, int G) { int s = 1; if (nR * 8 * 2 <= G) s = 2; if (nR * 8 * 4 <= G) s = 4; if (nR * 8 * 7 <= G) s = 7; if (nR * 8 * 14 <= G) s = 14; return s; }
enum { I_x, I_c, I_attn_norm_g, I_ada_w, I_ada_b, I_w_in, I_forget_b, I_moba_out_g, I_fox_out_g, I_w_o, I_ffn_norm_g, I_dense_w_gate, I_dense_w_up, I_dense_w_down,
       I_router_w, I_moe_w_gate, I_moe_w_up, I_moe_w_down, I_final_norm_g, N_IN };
struct Args { const float* in[N_IN]; float* out; unsigned char* ws; };
__device__ __forceinline__ const float* inp(const unsigned char* ws, int i) {
    const unsigned long long v = __hip_atomic_load((GAS unsigned long long*)(ws + WS_TAB) + i, __ATOMIC_RELAXED, __HIP_MEMORY_SCOPE_AGENT);
    const unsigned lo = (unsigned)__builtin_amdgcn_readfirstlane((int)(unsigned)v), hi = (unsigned)__builtin_amdgcn_readfirstlane((int)(unsigned)(v >> 32));
    return (const float*)(((unsigned long long)hi << 32) | lo);
}
#define INP(name) inp(a.ws, I_##name)
struct Frame {
    LAS unsigned char* lds; volatile LAS unsigned* MISC; gu32* ctl;
    int tid, lane, wave, vcu, G;
};

template <int MAP> __device__ __forceinline__ int map_row(int c) {
    if (MAP == 1) { if (c >= 2048) return c; const int d = c & 127, dd = d & 63; return (c & ~127) + 8 * (dd >> 2) + 4 * (d >> 6) + (dd & 3); }
    if (MAP == 2) return (c >> 7) * 256 + (c & 127);
    if (MAP == 3) return (c >> 7) * 256 + 128 + (c & 127);
    return c;
}
template <int MAP>
__device__ __forceinline__ void transpose_item(const float* W, int ldw, int K, int nblk, bf16* WT, const float* kscale, LAS float* scr, int item, int lane) {
    const int kb = item / nblk, nb = item - kb * nblk, k0 = 64 * kb, n0 = 32 * nb;
#pragma unroll
    for (int i = 0; i < 8; ++i) { const int kk = 8 * i + (lane >> 3), c4 = (lane & 7) * 4; f32x4 v = *(const GAS f32x4*)(W + (size_t)(k0 + kk) * ldw + n0 + c4); if (kscale) v = v * kscale[k0 + kk];
        LAS float* d = scr + kk * 33 + c4; d[0] = v.x; d[1] = v.y; d[2] = v.z; d[3] = v.w; }
    LDS_WAIT(); asm volatile("" ::: "memory");
    const int c = lane & 7;
#pragma unroll
    for (int j = 0; j < 4; ++j) { const int n = (lane >> 3) + 8 * j; const LAS float* s = scr + (8 * c) * 33 + n;
        v4u o; o.x = pg8::cvt_pk_bf16(s[0 * 33], s[1 * 33]); o.y = pg8::cvt_pk_bf16(s[2 * 33], s[3 * 33]); o.z = pg8::cvt_pk_bf16(s[4 * 33], s[5 * 33]); o.w = pg8::cvt_pk_bf16(s[6 * 33], s[7 * 33]);
        *(GAS v4u*)(WT + (size_t)map_row<MAP>(n0 + n) * K + k0 + 8 * c) = o; }
    LDS_WAIT(); asm volatile("" ::: "memory");
}
template <int MAP>
__device__ __forceinline__ void transpose_item8(const float* W, int ldw, int K, int nblk, unsigned char* WT, float scale, LAS float* scr, int item, int lane) {
    const int kb = item / nblk, nb = item - kb * nblk, k0 = 128 * kb, n0 = 32 * nb;
#pragma unroll
    for (int i = 0; i < 16; ++i) { const int kk = 8 * i + (lane >> 3), c4 = (lane & 7) * 4; const f32x4 v = *(const GAS f32x4*)(W + (size_t)(k0 + kk) * ldw + n0 + c4) * scale;
        LAS float* d = scr + kk * 33 + c4; d[0] = v.x; d[1] = v.y; d[2] = v.z; d[3] = v.w; }
    LDS_WAIT(); asm volatile("" ::: "memory");
    const int c = lane & 7;
#pragma unroll
    for (int j = 0; j < 4; ++j) { const int n = (lane >> 3) + 8 * j; const LAS float* s = scr + (16 * c) * 33 + n;
        v4u o; o.x = pg8::pk_fp8x4(s[0 * 33], s[1 * 33], s[2 * 33], s[3 * 33]); o.y = pg8::pk_fp8x4(s[4 * 33], s[5 * 33], s[6 * 33], s[7 * 33]);
        o.z = pg8::pk_fp8x4(s[8 * 33], s[9 * 33], s[10 * 33], s[11 * 33]); o.w = pg8::pk_fp8x4(s[12 * 33], s[13 * 33], s[14 * 33], s[15 * 33]);
        *(GAS v4u*)(WT + (size_t)map_row<MAP>(n0 + n) * K + k0 + 16 * c) = o; }
    LDS_WAIT(); asm volatile("" ::: "memory");
}
__device__ __forceinline__ void p0a(Frame& F0, const Args& a) {
    Frame F = F0; asm volatile("" : "+v"(F.tid), "+v"(F.lane));
    LAS float* ca = (LAS float*)(F.lds + RING_OFF);
    for (int i = F.tid; i < NB * DM; i += NWAVES * 64) { const float v = a.in[I_c][i]; ca[i] = v / (1.f + expf(-v)); }
    __syncthreads();
    const int gw = F.vcu * NWAVES + F.wave, NGW = F.G * NWAVES;
    float* part = (float*)(a.ws + WS_PART);
    for (int it = gw; it < 2 * 32 * 48; it += NGW) {
        const int cg = it % 48, lc = it / 48, chunk = lc & 31, l = lc >> 5, j0 = cg * 256 + 4 * F.lane;
        const float* w = a.in[I_ada_w] + ((size_t)l * DM + chunk * 64) * 12288 + j0;
        f32x4 s0 = {0.f, 0.f, 0.f, 0.f}, s1 = s0, s2 = s0, s3 = s0;
#pragma unroll 16
        for (int dd = 0; dd < 64; ++dd) { const f32x4 wv = *(const GAS f32x4*)(w + (size_t)dd * 12288); const int d = chunk * 64 + dd;
            s0 += ca[d] * wv; s1 += ca[DM + d] * wv; s2 += ca[2 * DM + d] * wv; s3 += ca[3 * DM + d] * wv; }
        float* pp = part + ((size_t)(chunk * 2 + l) * 4) * 12288 + j0;
        *(f32x4*)(pp) = s0; *(f32x4*)(pp + 12288) = s1; *(f32x4*)(pp + 2 * 12288) = s2; *(f32x4*)(pp + 3 * 12288) = s3;
    }
    const int gt = F.vcu * (NWAVES * 64) + F.tid, NGT = F.G * NWAVES * 64;
    float* ropeT = (float*)(a.ws + WS_ROPE);
    for (int i = gt; i < SEQ * 64; i += NGT) {
        const int pos = i >> 6, dp = i & 63;
        const float invf = (float)exp2(-(double)(2 * dp) / 128.0 * 13.287712379549449);
        const float angf = (float)pos * invf;
        float* t = ropeT + ((size_t)pos * 16 + (dp >> 2)) * 8 + (dp & 3);
        t[0] = (float)cos((double)angf); t[4] = (float)sin((double)angf);
    }
    float* wfz = (float*)(a.ws + WS_WFZ);
    for (int i = gt; i < NLAYER * 8 * DM; i += NGT) { const int d = i & (DM - 1), j = (i >> 11) & 7, l = i >> 14; wfz[i] = a.in[I_w_in][((size_t)l * DM + d) * INW + NQKV + j]; }
    if (F.tid == 0) { GAS unsigned long long* tab = (GAS unsigned long long*)(a.ws + WS_TAB);
#pragma unroll
        for (int i = 0; i < N_IN; ++i) tab[i] = (unsigned long long)a.in[i]; }
}
__device__ __forceinline__ bool conv_split(int G) { return CONV_SPLIT && DENSE_FP8 && G == 256; }
template <int MODE>
__device__ __forceinline__ void p0b(Frame& F0, const Args& a) {
    Frame F = F0; asm volatile("" : "+v"(F.tid), "+v"(F.lane));
    if (MODE == 0) {
    const int gt = F.vcu * (NWAVES * 64) + F.tid, NGT = F.G * NWAVES * 64;
    const float* part = (const float*)(a.ws + WS_PART); float* mod = (float*)(a.ws + WS_MOD); const float* adab = INP(ada_b);
    for (int i = gt; i < NLAYER * NB * 12288; i += NGT) {
        const int j = i % 12288, l = i / (4 * 12288); float s = adab[l * 12288 + j];
#pragma unroll 8
        for (int ch = 0; ch < 32; ++ch) s += part[(size_t)ch * (8 * 12288) + i];
        mod[i] = s;
    }
    }
    LAS float* scr = (LAS float*)(F.lds + RING_OFF + F.wave * 16896);
    constexpr int CCUS = MODE == 1 ? CONV_CUS_A : CONV_CUS_B;
    const int gw = MODE == 0 ? F.vcu * NWAVES + F.wave : ((int)blockIdx.x - (F.G - CCUS)) * NWAVES + F.wave, NGW = MODE == 0 ? F.G * NWAVES : CCUS * NWAVES;
    constexpr int I_IN = 32 * 192, I_O = 32 * 64, I_GU = 32 * 224, I_D = 112 * 64;
    constexpr int J_GU = 16 * 224, J_D = 56 * 64;
    constexpr int PER8 = 2 * J_GU + J_D, PER16 = 2 * I_GU + I_D, N8 = DENSE_FP8 ? 9 : 8;
    constexpr int NITEMS = NLAYER * (I_IN + I_O) + N8 * PER8 + (DENSE_FP8 ? 0 : PER16);
    const float* p_w_in = INP(w_in); const float* p_w_o = INP(w_o); const float* p_mg = INP(moba_out_g); const float* p_fg = INP(fox_out_g);
    const float* p_dg = INP(dense_w_gate); const float* p_du = INP(dense_w_up); const float* p_dd = INP(dense_w_down);
    const float* p_eg = INP(moe_w_gate); const float* p_eu = INP(moe_w_up); const float* p_ed = INP(moe_w_down);
    unsigned char* wsb = a.ws;
    struct Item { const float* src; unsigned char* dst; const float* ksc; int ldw, K, nload, map, fp8; float scale; };
    auto decode = [&](int it) -> Item {
        Item d; int r = it; d.ksc = nullptr; d.scale = 1.f; d.fp8 = 0; d.nload = 8;
        if (r < NLAYER * I_IN) { const int l = r / I_IN; r -= l * I_IN; const int kb = r / 192, nb = r - kb * 192;
            d.src = p_w_in + (size_t)l * DM * INW + (size_t)(64 * kb) * INW + 32 * nb; d.ldw = INW; d.K = DM; d.map = 1;
            d.dst = wsb + WS_WIN + ((size_t)l * NQKV * DM + 64 * kb) * 2; d.scale = __int_as_float(32 * nb); return d; }
        r -= NLAYER * I_IN;
        if (r < NLAYER * I_O) { const int l = r / I_O; r -= l * I_O; const int kb = r / 64, nb = r - kb * 64;
            d.src = p_w_o + (size_t)l * DM * DM + (size_t)(64 * kb) * DM + 32 * nb; d.ldw = DM; d.K = DM; d.map = 0;
            d.ksc = ((kb < 16) ? p_mg + l * 1024 : p_fg + l * 1024 - 1024) + 64 * kb;
            d.dst = wsb + WS_WO + ((size_t)l * DM * DM + 64 * kb) * 2; d.scale = __int_as_float(32 * nb); return d; }
        r -= NLAYER * I_O;
        if (r < N8 * PER8) { int e = r / PER8; r -= e * PER8; if (!DENSE_FP8) e += 1;
            d.fp8 = 1; d.nload = 16;
            unsigned char* wgu8 = e ? wsb + WS_WGU8 + (size_t)(e - 1) * NGU * DM : wsb + WS_WGU;
            unsigned char* wd8 = e ? wsb + WS_WD8 + (size_t)(e - 1) * DM * DFF : wsb + WS_WD;
            if (r < 2 * J_GU) { const int up = r >= J_GU; if (up) r -= J_GU; const int kb = r / 224, nb = r - kb * 224;
                const float* sp = up ? (e == 0 ? p_du : p_eu + (size_t)(e - 1) * DM * DFF) : (e == 0 ? p_dg : p_eg + (size_t)(e - 1) * DM * DFF);
                d.src = sp + (size_t)(128 * kb) * DFF + 32 * nb; d.ldw = DFF; d.K = DM; d.map = up ? 3 : 2; d.dst = wgu8 + 128 * kb; d.ksc = nullptr; d.scale = __int_as_float(32 * nb); d.fp8 = 1 + 64; return d; }
            r -= 2 * J_GU; { const int kb = r / 64, nb = r - kb * 64; const float* sp = e == 0 ? p_dd : p_ed + (size_t)(e - 1) * DM * DFF;
                d.src = sp + (size_t)(128 * kb) * DM + 32 * nb; d.ldw = DM; d.K = DFF; d.map = 0; d.dst = wd8 + 128 * kb; d.scale = __int_as_float(32 * nb); d.fp8 = 1 + 128; return d; } }
        r -= N8 * PER8;
        if (r < 2 * I_GU) { const int up = r >= I_GU; if (up) r -= I_GU; const int kb = r / 224, nb = r - kb * 224;
            d.src = (up ? p_du : p_dg) + (size_t)(64 * kb) * DFF + 32 * nb; d.ldw = DFF; d.K = DM; d.map = up ? 3 : 2; d.dst = wsb + WS_WGU + (size_t)(64 * kb) * 2; d.scale = __int_as_float(32 * nb); return d; }
        r -= 2 * I_GU; { const int kb = r / 64, nb = r - kb * 64;
            d.src = p_dd + (size_t)(64 * kb) * DM + 32 * nb; d.ldw = DM; d.K = DFF; d.map = 0; d.dst = wsb + WS_WD + (size_t)(64 * kb) * 2; d.scale = __int_as_float(32 * nb); return d; }
    };
    auto load = [&](const Item& d, f32x4 (&buf)[16]) {
        const float* s = d.src + (size_t)(F.lane >> 3) * d.ldw + (F.lane & 7) * 4;
#pragma unroll
        for (int i = 0; i < 8; ++i) buf[i] = *(const GAS f32x4*)(s + (size_t)(8 * i) * d.ldw);
        if (d.nload == 16) {
#pragma unroll
            for (int i = 8; i < 16; ++i) buf[i] = *(const GAS f32x4*)(s + (size_t)(8 * i) * d.ldw); }
    };
    auto mapr = [&](int map, int c) -> int {
        if (map == 1) { if (c >= 2048) return c; const int dd_ = c & 127, d6 = dd_ & 63; return (c & ~127) + 8 * (d6 >> 2) + 4 * (dd_ >> 6) + (d6 & 3); }
        if (map == 2) return (c >> 7) * 256 + (c & 127);
        if (map == 3) return (c >> 7) * 256 + 128 + (c & 127);
        return c; };
    auto process = [&](const Item& d, const f32x4 (&buf)[16]) {
        const int n0 = __float_as_int(d.scale), c4 = (F.lane & 7) * 4, c = F.lane & 7;
        if (d.fp8 & 1) {
            const float sc = (d.fp8 & 128) ? 128.f : 64.f;
#pragma unroll
            for (int i = 0; i < 16; ++i) { const int kk = 8 * i + (F.lane >> 3); const f32x4 v = buf[i] * sc; LAS float* q = scr + kk * 33 + c4; q[0] = v.x; q[1] = v.y; q[2] = v.z; q[3] = v.w; }
            LDS_WAIT(); asm volatile("" ::: "memory");
#pragma unroll
            for (int j = 0; j < 4; ++j) { const int n = (F.lane >> 3) + 8 * j; const LAS float* s = scr + (16 * c) * 33 + n;
                v4u o; o.x = pg8::pk_fp8x4(s[0 * 33], s[1 * 33], s[2 * 33], s[3 * 33]); o.y = pg8::pk_fp8x4(s[4 * 33], s[5 * 33], s[6 * 33], s[7 * 33]);
                o.z = pg8::pk_fp8x4(s[8 * 33], s[9 * 33], s[10 * 33], s[11 * 33]); o.w = pg8::pk_fp8x4(s[12 * 33], s[13 * 33], s[14 * 33], s[15 * 33]);
                *(GAS v4u*)(d.dst + (size_t)mapr(d.map, n0 + n) * d.K + 16 * c) = o; }
        } else {
#pragma unroll
            for (int i = 0; i < 8; ++i) { const int kk = 8 * i + (F.lane >> 3); f32x4 v = buf[i]; if (d.ksc) v = v * d.ksc[kk]; LAS float* q = scr + kk * 33 + c4; q[0] = v.x; q[1] = v.y; q[2] = v.z; q[3] = v.w; }
            LDS_WAIT(); asm volatile("" ::: "memory");
#pragma unroll
            for (int j = 0; j < 4; ++j) { const int n = (F.lane >> 3) + 8 * j; const LAS float* s = scr + (8 * c) * 33 + n;
                v4u o; o.x = pg8::cvt_pk_bf16(s[0 * 33], s[1 * 33]); o.y = pg8::cvt_pk_bf16(s[2 * 33], s[3 * 33]); o.z = pg8::cvt_pk_bf16(s[4 * 33], s[5 * 33]); o.w = pg8::cvt_pk_bf16(s[6 * 33], s[7 * 33]);
                *(GAS v4u*)(d.dst + ((size_t)mapr(d.map, n0 + n) * d.K + 8 * c) * 2) = o; }
        }
        LDS_WAIT(); asm volatile("" ::: "memory");
    };
    f32x4 bufA[16], bufB[16]; Item cur, nxt;
    constexpr int EARLY0 = NLAYER * (I_IN + I_O) + (DENSE_FP8 ? PER8 : 0), EARLY = EARLY0 + (int)((long long)(NITEMS - EARLY0) * CONV_KEEP_PCT / 100), MID = EARLY + (int)((long long)(NITEMS - EARLY0) * CONV_A_PCT / 100);
    const bool sp = conv_split(F.G);
    const int lo = MODE == 0 ? 0 : MODE == 1 ? EARLY : MID, hi = MODE == 0 ? (sp ? EARLY : NITEMS) : MODE == 1 ? MID : NITEMS;
    int it = lo + gw;
    if (it < hi) { cur = decode(it); load(cur, bufA); }
    while (it < hi) {
        int nit = it + NGW; bool hn = nit < hi;
        if (hn) { nxt = decode(nit); load(nxt, bufB); }
        process(cur, bufA);
        if (!hn) break;
        it = nit; nit = it + NGW; hn = nit < hi;
        if (hn) { cur = decode(nit); load(cur, bufA); }
        process(nxt, bufB);
        if (!hn) break;
        it = nit;
    }
}
__device__ __forceinline__ float reduce8(const float (&v)[8], int lane) {
    float a[4], b[2], c;
    const bool u32 = (lane & 32) != 0, u16 = (lane & 16) != 0, u8 = (lane & 8) != 0;
#pragma unroll
    for (int i = 0; i < 4; ++i) { const float send = u32 ? v[i] : v[i + 4], keep = u32 ? v[i + 4] : v[i]; a[i] = keep + __shfl_xor(send, 32); }
#pragma unroll
    for (int i = 0; i < 2; ++i) { const float send = u16 ? a[i] : a[i + 2], keep = u16 ? a[i + 2] : a[i]; b[i] = keep + __shfl_xor(send, 16); }
    { const float send = u8 ? b[0] : b[1], keep = u8 ? b[1] : b[0]; c = keep + __shfl_xor(send, 8); }
    c += __shfl_xor(c, 4); c += __shfl_xor(c, 2); c += __shfl_xor(c, 1);
    return c;
}
template <int MODE, bool XB16>
__device__ __forceinline__ void norm_phase(Frame& F0, const Args& a, const void* xin_  , const float* g, const float* modl  , int shc  ,
                                           const float* aux  , const float* fb, bf16* H) {
    Frame F = F0; asm volatile("" : "+v"(F.tid), "+v"(F.lane));
    LAS float* A = (LAS float*)(F.lds + RING_OFF); LAS float* B = A + DM; LAS float* W = B + DM;
    LAS int* rt = (LAS int*)(W + 8 * DM);
    if (MODE == 0) { for (int i = F.tid; i < 2 * DM; i += NWAVES * 64) *(LAS f32x4*)(W + 4 * i) = *(const GAS f32x4*)(aux + 4 * i);
        float* ks = (float*)(a.ws + WS_KMEAN); for (int i = F.vcu * (NWAVES * 64) + F.tid; i < 32 * 16 * 128; i += F.G * NWAVES * 64) ks[i] = 0.f; }
    if (MODE == 1) { for (int d = F.tid; d < DM; d += NWAVES * 64) { const f32x4 r0 = *(const GAS f32x4*)(aux + 8 * d), r1 = *(const GAS f32x4*)(aux + 8 * d + 4);
            W[d] = r0.x; W[DM + d] = r0.y; W[2 * DM + d] = r0.z; W[3 * DM + d] = r0.w; W[4 * DM + d] = r1.x; W[5 * DM + d] = r1.y; W[6 * DM + d] = r1.z; W[7 * DM + d] = r1.w; } }
    constexpr bool F8OUT = (MODE == 1) || (MODE == 2 && DENSE_FP8);
    int lastb = -1;
    for (int chunk = F.vcu; chunk < NTOK / 64; chunk += F.G) {
        const int b = chunk >> 6;
        if (b != lastb) { __syncthreads();
            for (int i = F.tid; i < DM; i += NWAVES * 64) { A[i] = g[i] * (1.f + modl[(size_t)b * 12288 + (shc + 1) * DM + i]); B[i] = modl[(size_t)b * 12288 + shc * DM + i]; }
            lastb = b; }
        __syncthreads();
#pragma unroll 1
        for (int rp = 0; rp < 4; ++rp) {
            const int row0 = chunk * 64 + F.wave * 8 + rp * 2;
            f32x4 v[2][8]; float ss[2] = {0.f, 0.f};
            if (!XB16) {
#pragma unroll
                for (int r2 = 0; r2 < 2; ++r2) { const GAS f32x4* xr = (const GAS f32x4*)((const float*)xin_ + (size_t)(row0 + r2) * DM) + F.lane;
#pragma unroll
                    for (int j = 0; j < 8; ++j) v[r2][j] = xr[64 * j]; }
            } else { v2u w[2][8];
#pragma unroll
                for (int r2 = 0; r2 < 2; ++r2) { const GAS v2u* xr = (const GAS v2u*)((const bf16*)xin_ + (size_t)(row0 + r2) * DM) + F.lane;
#pragma unroll
                    for (int j = 0; j < 8; ++j) w[r2][j] = xr[64 * j]; }
#pragma unroll
                for (int r2 = 0; r2 < 2; ++r2)
#pragma unroll
                    for (int j = 0; j < 8; ++j) v[r2][j] = (f32x4){__builtin_bit_cast(float, w[r2][j].x << 16), __builtin_bit_cast(float, w[r2][j].x & 0xffff0000u), __builtin_bit_cast(float, w[r2][j].y << 16), __builtin_bit_cast(float, w[r2][j].y & 0xffff0000u)};
            }
#pragma unroll
            for (int r2 = 0; r2 < 2; ++r2)
#pragma unroll
                for (int j = 0; j < 8; ++j) ss[r2] += (v[r2][j].x * v[r2][j].x + v[r2][j].y * v[r2][j].y) + (v[r2][j].z * v[r2][j].z + v[r2][j].w * v[r2][j].w);
#pragma unroll
            for (int o = 1; o < 64; o <<= 1) { ss[0] += __shfl_xor(ss[0], o); ss[1] += __shfl_xor(ss[1], o); }
#pragma unroll
            for (int r2 = 0; r2 < 2; ++r2) {
                const int row = row0 + r2; const float rstd = 1.0f / sqrtf(ss[r2] * (1.f / DM) + EPS);
#pragma unroll
                for (int j = 0; j < 8; ++j) { const f32x4 av = *(const LAS f32x4*)(A + 256 * j + 4 * F.lane), bv = *(const LAS f32x4*)(B + 256 * j + 4 * F.lane);
                    v[r2][j] = v[r2][j] * rstd * av + bv;
                    if (F8OUT) ((GAS unsigned*)((unsigned char*)H + (size_t)row * DM))[64 * j + F.lane] = pg8::pk_fp8x4(v[r2][j].x, v[r2][j].y, v[r2][j].z, v[r2][j].w);
                    else { v2u w; w.x = pg8::cvt_pk_bf16(v[r2][j].x, v[r2][j].y); w.y = pg8::cvt_pk_bf16(v[r2][j].z, v[r2][j].w); ((GAS v2u*)(H + (size_t)row * DM) + F.lane)[64 * j] = w; } }
            }
            float t2[2][8];
            if (MODE != 2) {
                f32x4 wq[2][8];
#pragma unroll
                for (int j = 0; j < 8; ++j) wq[0][j] = *(const LAS f32x4*)(W + 256 * j + 4 * F.lane);
#pragma unroll
                for (int e = 0; e < 8; ++e) { f32x4 s0 = {0.f, 0.f, 0.f, 0.f}, s1 = s0;
                    __builtin_amdgcn_sched_barrier(0);
                    if (e + 1 < 8) {
#pragma unroll
                        for (int j = 0; j < 8; ++j) wq[(e + 1) & 1][j] = *(const LAS f32x4*)(W + (e + 1) * DM + 256 * j + 4 * F.lane); }
                    __builtin_amdgcn_sched_barrier(0);
#pragma unroll
                    for (int j = 0; j < 8; ++j) { s0 += v[0][j] * wq[e & 1][j]; s1 += v[1][j] * wq[e & 1][j]; }
                    t2[0][e] = (s0.x + s0.y) + (s0.z + s0.w); t2[1][e] = (s1.x + s1.y) + (s1.z + s1.w);
                    asm volatile("" : "+v"(t2[0][e]), "+v"(t2[1][e])); }
                __builtin_amdgcn_sched_barrier(0);
            }
#pragma unroll
            for (int r2 = 0; r2 < 2; ++r2) {
                const int row = row0 + r2;
                if (MODE != 2) {
                    const float tot = reduce8(t2[r2], F.lane);
                    if (MODE == 0) {
                        if ((F.lane & 7) == 0) { const int hh = F.lane >> 3; const float z = tot + fb[hh]; const float ls = fminf(z, 0.f) - log1pf(expf(-fabsf(z)));
                            ((float*)(a.ws + WS_LOGF))[((size_t)b * 8 + hh) * SEQ + (row & (SEQ - 1))] = ls; }
                    } else {
                        float lg[8];
#pragma unroll
                        for (int e = 0; e < 8; ++e) lg[e] = __uint_as_float((unsigned)__builtin_amdgcn_readlane((int)__float_as_uint(tot), 8 * e));
                        int i0 = 0, i1 = 0; float v0 = -__builtin_inff(), v1 = -__builtin_inff();
#pragma unroll
                        for (int e = 0; e < 8; ++e) if (lg[e] > v0) { v0 = lg[e]; i0 = e; }
#pragma unroll
                        for (int e = 0; e < 8; ++e) if (e != i0 && lg[e] > v1) { v1 = lg[e]; i1 = e; }
                        const float e1 = expf(v1 - v0), w0 = 1.f / (1.f + e1), w1 = e1 / (1.f + e1);
                        if (F.lane == 0) { int* te = (int*)(a.ws + WS_ROUTE); float* tw = (float*)(a.ws + WS_ROUTE + 131072);
                            te[row * 2] = i0; te[row * 2 + 1] = i1; tw[row * 2] = w0; tw[row * 2 + 1] = w1; rt[(row & 63) * 2] = i0; rt[(row & 63) * 2 + 1] = i1; }
                    }
                }
            }
        }
        if (MODE == 1) {
            __syncthreads();
            if (F.wave == 0) { const int e0 = rt[F.lane * 2], e1 = rt[F.lane * 2 + 1]; int r0 = 0, r1 = 0;
                int* rk = (int*)(a.ws + WS_ROUTE + 2 * 131072); int* cnt = (int*)(a.ws + WS_ROUTE + 4 * 131072);
#pragma unroll
                for (int e = 0; e < 8; ++e) { const unsigned long long bal = __ballot(e0 == e || e1 == e); const int pre = __popcll(bal & ((1ull << F.lane) - 1ull));
                    if (e0 == e) r0 = pre; if (e1 == e) r1 = pre; if (F.lane == 0) cnt[chunk * 8 + e] = __popcll(bal); }
                rk[(chunk * 64 + F.lane) * 2] = r0; rk[(chunk * 64 + F.lane) * 2 + 1] = r1; }
        }
    }
    __syncthreads();
}
__device__ __forceinline__ void outnorm_phase(Frame& F0, const Args& a) {
    Frame F = F0; asm volatile("" : "+v"(F.tid), "+v"(F.lane));
    bf16* ob = (bf16*)(a.ws + WS_O);
    for (int row = F.vcu * NWAVES + F.wave; row < NTOK; row += F.G * NWAVES) {
        GAS v4u* p = (GAS v4u*)(ob + (size_t)row * DM) + F.lane; v4u w[4]; float f[4][8]; float ss0 = 0.f, ss1 = 0.f;
#pragma unroll
        for (int j = 0; j < 4; ++j) w[j] = p[64 * j];
#pragma unroll
        for (int j = 0; j < 4; ++j) { const unsigned u4[4] = {w[j].x, w[j].y, w[j].z, w[j].w}; float s = 0.f;
#pragma unroll
            for (int q = 0; q < 4; ++q) { f[j][2 * q] = bf2f((unsigned short)(u4[q] & 0xffffu)); f[j][2 * q + 1] = bf2f((unsigned short)(u4[q] >> 16)); s += f[j][2 * q] * f[j][2 * q] + f[j][2 * q + 1] * f[j][2 * q + 1]; }
            if (j < 2) ss0 += s; else ss1 += s; }
        const float r0 = 1.0f / sqrtf(wave_sum(ss0) * (1.f / 1024.f) + EPS), r1 = 1.0f / sqrtf(wave_sum(ss1) * (1.f / 1024.f) + EPS);
#pragma unroll
        for (int j = 0; j < 4; ++j) { const float r = j < 2 ? r0 : r1; v4u o; o.x = pk2(f[j][0] * r, f[j][1] * r); o.y = pk2(f[j][2] * r, f[j][3] * r); o.z = pk2(f[j][4] * r, f[j][5] * r); o.w = pk2(f[j][6] * r, f[j][7] * r); p[64 * j] = o; }
    }
}
__device__ __forceinline__ void moe_gather_phase(Frame& F0, const Args& a) {
    Frame F = F0; asm volatile("" : "+v"(F.tid), "+v"(F.lane));
    LAS int* tile_e = (LAS int*)(F.lds + TILE_E_OFF);
    LAS int* sh = (LAS int*)(F.lds + RING_OFF);
    const int* cnt = (const int*)(a.ws + WS_ROUTE + 4 * 131072); const int* te = (const int*)(a.ws + WS_ROUTE); const int* rk = (const int*)(a.ws + WS_ROUTE + 2 * 131072);
    int* slot = (int*)(a.ws + WS_ROUTE + 3 * 131072);
    const bf16* H = (const bf16*)(a.ws + WS_H); bf16* HS = (bf16*)(a.ws + WS_HS);
    for (int chunk = F.vcu; chunk < NTOK / 64; chunk += F.G) {
        __syncthreads();
        if (F.wave == 0) {
            int tot[8], bef[8];
#pragma unroll
            for (int e = 0; e < 8; ++e) { tot[e] = 0; bef[e] = 0; }
            for (int c = F.lane; c < 256; c += 64) {
#pragma unroll
                for (int e = 0; e < 8; ++e) { const int v = cnt[c * 8 + e]; tot[e] += v; if (c < chunk) bef[e] += v; } }
#pragma unroll
            for (int e = 0; e < 8; ++e) {
#pragma unroll
                for (int o = 1; o < 64; o <<= 1) { tot[e] += __shfl_xor(tot[e], o); bef[e] += __shfl_xor(bef[e], o); } }
            if (F.lane == 0) { int off = 0;
#pragma unroll
                for (int e = 0; e < 8; ++e) { sh[e] = tot[e]; sh[8 + e] = off; sh[32 + e] = bef[e]; const int nt = (tot[e] + 255) >> 8;
                    for (int t = 0; t < nt; ++t) tile_e[(off >> 8) + t] = e; off += nt << 8; }
                sh[16] = off; tile_e[140] = off >> 8; }
        }
        __syncthreads();
        LAS int* sl = sh + 64;
        if (F.wave == 0) { const int t = chunk * 64 + F.lane;
#pragma unroll
            for (int k = 0; k < 2; ++k) { const int e = te[t * 2 + k]; const int s = sh[8 + e] + sh[32 + e] + rk[t * 2 + k]; slot[t * 2 + k] = s; sl[F.lane * 2 + k] = s; } }
        __syncthreads();
        for (int cp0 = F.wave; cp0 < 128; cp0 += 4 * NWAVES) {
            v4u w[4][2];
#pragma unroll
            for (int q = 0; q < 4; ++q) { const int cp = cp0 + q * NWAVES, tl = cp >> 1; const GAS v4u* src = (const GAS v4u*)((const unsigned char*)H + (size_t)(chunk * 64 + tl) * DM) + F.lane;
#pragma unroll
                for (int j = 0; j < 2; ++j) w[q][j] = src[64 * j]; }
#pragma unroll
            for (int q = 0; q < 4; ++q) { const int s = sl[cp0 + q * NWAVES]; GAS v4u* dst = (GAS v4u*)((unsigned char*)HS + (size_t)s * DM) + F.lane;
#pragma unroll
                for (int j = 0; j < 2; ++j) dst[64 * j] = w[q][j]; } }
    }
    __syncthreads();
}
__device__ __forceinline__ void final_phase(Frame& F0, const Args& a, const bf16* x1  , const float* gf  , float* outp) {
    Frame F = F0; asm volatile("" : "+v"(F.tid), "+v"(F.lane));
    const float* fng = INP(final_norm_g);
    const LAS int* tile_e_ = (const LAS int*)(F.lds + TILE_E_OFF); const int nM_ = __builtin_amdgcn_readfirstlane(tile_e_[140]);
    const int nR_ = MOE_SPLIT ? nM_ % 32 : 0, nF256 = (nM_ - nR_) * 256, SS_ = nR_ ? moe_split_s(nR_, F.G) : 1; const float* YP = (const float*)(a.ws + WS_YP);
    const bf16* YS = (const bf16*)(a.ws + WS_YS); const int* slot = (const int*)(a.ws + WS_ROUTE + 3 * 131072); const float* tw = (const float*)(a.ws + WS_ROUTE + 131072);
    f32x4 fgv[8];
#pragma unroll
    for (int j = 0; j < 4; ++j) { fgv[2 * j] = ((const GAS f32x4*)fng)[128 * j + 2 * F.lane]; fgv[2 * j + 1] = ((const GAS f32x4*)fng)[128 * j + 2 * F.lane + 1]; }
    const int stride = F.G * NWAVES, rowA = F.vcu * NWAVES + F.wave;
    int sa0 = slot[rowA * 2], sa1 = slot[rowA * 2 + 1]; float wa0 = tw[rowA * 2], wa1 = tw[rowA * 2 + 1];
    int sb0 = 0, sb1 = 0; float wb0 = 0.f, wb1 = 0.f;
    if (rowA + stride < NTOK) { const int r_ = rowA + stride; sb0 = slot[r_ * 2]; sb1 = slot[r_ * 2 + 1]; wb0 = tw[r_ * 2]; wb1 = tw[r_ * 2 + 1]; }
    v4u xw[4], yv[2][4]; f32x4 gv[8];
#define FINAL_LOADS(ROW, S0, S1) do { const GAS v4u* xr_ = (const GAS v4u*)(x1 + (size_t)(ROW) * DM) + F.lane; const GAS v4u* y0_ = (const GAS v4u*)(YS + (size_t)(S0) * DM) + F.lane; const GAS v4u* y1_ = (const GAS v4u*)(YS + (size_t)(S1) * DM) + F.lane; \
        const GAS f32x4* gp_ = (const GAS f32x4*)(gf + (size_t)((ROW) >> 12) * 12288); \
        _Pragma("unroll") for (int j = 0; j < 4; ++j) { xw[j] = xr_[64 * j]; yv[0][j] = y0_[64 * j]; yv[1][j] = y1_[64 * j]; } \
        _Pragma("unroll") for (int j = 0; j < 4; ++j) { gv[2 * j] = gp_[128 * j + 2 * F.lane]; gv[2 * j + 1] = gp_[128 * j + 2 * F.lane + 1]; } } while (0)
    FINAL_LOADS(rowA, sa0, sa1);
#pragma unroll 1
    for (int row = rowA; row < NTOK; row += stride) {
        f32x4 v[8]; float s = 0.f; float yy[4][8];
#pragma unroll
        for (int j = 0; j < 4; ++j) {
#pragma unroll
            for (int q = 0; q < 8; ++q) yy[j][q] = 0.f; }
#pragma unroll
        for (int k = 0; k < 2; ++k) {
            const int sk = k ? sa1 : sa0; const float wk = k ? wa1 : wa0;
            if (sk < nF256) {
#pragma unroll
                for (int j = 0; j < 4; ++j) { const unsigned u4[4] = {yv[k][j].x, yv[k][j].y, yv[k][j].z, yv[k][j].w};
#pragma unroll
                    for (int q = 0; q < 4; ++q) { yy[j][2 * q] += __builtin_bit_cast(float, u4[q] << 16) * wk; yy[j][2 * q + 1] += __builtin_bit_cast(float, u4[q] & 0xffff0000u) * wk; } }
            } else {
                for (int ks = 0; ks < SS_; ++ks) { const GAS f32x4* pr = (const GAS f32x4*)(YP + ((size_t)ks * nR_ * 256 + (sk - nF256)) * DM);
#pragma unroll
                    for (int j = 0; j < 4; ++j) { const f32x4 p0 = pr[128 * j + 2 * F.lane], p1 = pr[128 * j + 2 * F.lane + 1];
                        yy[j][0] += p0.x * wk; yy[j][1] += p0.y * wk; yy[j][2] += p0.z * wk; yy[j][3] += p0.w * wk; yy[j][4] += p1.x * wk; yy[j][5] += p1.y * wk; yy[j][6] += p1.z * wk; yy[j][7] += p1.w * wk; } }
            }
        }
#pragma unroll
        for (int j = 0; j < 4; ++j) { const float (&y)[8] = yy[j]; const v4u w = xw[j];
            const f32x4 xa = {__builtin_bit_cast(float, w.x << 16), __builtin_bit_cast(float, w.x & 0xffff0000u), __builtin_bit_cast(float, w.y << 16), __builtin_bit_cast(float, w.y & 0xffff0000u)};
            const f32x4 xb = {__builtin_bit_cast(float, w.z << 16), __builtin_bit_cast(float, w.z & 0xffff0000u), __builtin_bit_cast(float, w.w << 16), __builtin_bit_cast(float, w.w & 0xffff0000u)};
            v[2 * j] = xa + gv[2 * j] * (f32x4){y[0], y[1], y[2], y[3]}; v[2 * j + 1] = xb + gv[2 * j + 1] * (f32x4){y[4], y[5], y[6], y[7]};
            s += (v[2 * j].x * v[2 * j].x + v[2 * j].y * v[2 * j].y) + (v[2 * j].z * v[2 * j].z + v[2 * j].w * v[2 * j].w) + (v[2 * j + 1].x * v[2 * j + 1].x + v[2 * j + 1].y * v[2 * j + 1].y) + (v[2 * j + 1].z * v[2 * j + 1].z + v[2 * j + 1].w * v[2 * j + 1].w); }
        __builtin_amdgcn_sched_barrier(0);
        { const int nr = row + stride;
          if (nr < NTOK) { FINAL_LOADS(nr, sb0, sb1); }
          sa0 = sb0; sa1 = sb1; wa0 = wb0; wa1 = wb1;
          const int nnr = nr + stride; if (nnr < NTOK) { sb0 = slot[nnr * 2]; sb1 = slot[nnr * 2 + 1]; wb0 = tw[nnr * 2]; wb1 = tw[nnr * 2 + 1]; } }
        __builtin_amdgcn_sched_barrier(0);
        const float rstd = 1.0f / sqrtf(wave_sum(s) * (1.f / DM) + EPS);
        GAS f32x4* o = (GAS f32x4*)(outp + (size_t)row * DM);
#pragma unroll
        for (int j = 0; j < 4; ++j) { o[128 * j + 2 * F.lane] = v[2 * j] * rstd * fgv[2 * j]; o[128 * j + 2 * F.lane + 1] = v[2 * j + 1] * rstd * fgv[2 * j + 1]; }
    }
#undef FINAL_LOADS
}

#ifndef REP_NORM3
#define REP_NORM3 1
#endif
#ifndef REP_FINAL
#define REP_FINAL 1
#endif
#ifndef REP_NORM2
#define REP_NORM2 1
#endif
#ifndef EXTRA_BARS
#define EXTRA_BARS 0
#endif
#ifndef REP_P0
#define REP_P0 1
#endif
#ifndef REP_INPROJ
#define REP_INPROJ 1
#endif
#ifndef REP_ATTN
#define REP_ATTN 1
#endif
#ifndef REP_WO
#define REP_WO 1
#endif
#ifndef REP_DUP
#define REP_DUP 1
#endif
#ifndef REP_DDOWN
#define REP_DDOWN 1
#endif
#ifndef REP_MUP
#define REP_MUP 1
#endif
#ifndef REP_MDOWN
#define REP_MDOWN 1
#endif
#ifndef REP_NORM1
#define REP_NORM1 1
#endif
#ifndef REP_SCAN
#define REP_SCAN 1
#endif
#ifndef REP_OUTNORM
#define REP_OUTNORM 1
#endif
#ifndef REP_GATHER
#define REP_GATHER 1
#endif
#ifndef PH_P0
#define PH_P0 1
#endif
#ifndef PH_NORM1
#define PH_NORM1 1
#endif
#ifndef PH_INPROJ
#define PH_INPROJ 1
#endif
#ifndef PH_SCAN
#define PH_SCAN 1
#endif
#ifndef PH_MOBA
#define PH_MOBA 1
#endif
#ifndef PH_FOX
#define PH_FOX 1
#endif
#ifndef PH_OUTNORM
#define PH_OUTNORM 1
#endif
#ifndef PH_WO
#define PH_WO 1
#endif
#ifndef PH_NORM2
#define PH_NORM2 1
#endif
#ifndef PH_DUP
#define PH_DUP 1
#endif
#ifndef PH_DDOWN
#define PH_DDOWN 1
#endif
#ifndef PH_NORM3
#define PH_NORM3 1
#endif
#ifndef PH_GATHER
#define PH_GATHER 1
#endif
#ifndef PH_MUP
#define PH_MUP 1
#endif
#ifndef PH_MDOWN
#define PH_MDOWN 1
#endif
#ifndef PH_FINAL
#define PH_FINAL 1
#endif
template <int l>
__device__ __forceinline__ void layer_body(Frame& F, const Args& args, const XcdBarrier& bar) {
    unsigned char* ws = args.ws;
    bf16* H = (bf16*)(ws + WS_H); bf16* QKV = (bf16*)(ws + WS_QKV); bf16* OB = (bf16*)(ws + WS_O);
    const float* mod = (const float*)(ws + WS_MOD);
#define GRID_BAR() xcd_barrier(bar)
        const float* modl = mod + (size_t)l * NB * 12288;
        bf16* XB = (bf16*)(ws + WS_XB);
        const void* xin = (l == 0) ? (const void*)inp(ws, I_x) : (const void*)XB;
#if PH_NORM1
for (int rep_ = 0; rep_ < REP_NORM1; ++rep_) {
        norm_phase<0, l != 0>(F, args, xin, inp(ws, I_attn_norm_g) + l * DM, modl, 0, (const float*)(ws + WS_WFZ) + (size_t)l * 8 * DM, inp(ws, I_forget_b) + l * 8, H);
#endif
        GRID_BAR();
}
#if PH_INPROJ
for (int rep_ = 0; rep_ < REP_INPROJ; ++rep_) {
        if (l == 0 && conv_split(F.G) && (int)blockIdx.x >= F.G - CONV_CUS_A) p0b<1>(F, args);
        else { const int Gg = (l == 0 && conv_split(F.G)) ? F.G - CONV_CUS_A : F.G;
          pg8::Gemm g{H, (const bf16*)(ws + WS_WIN) + (size_t)l * NQKV * DM, NTOK, NQKV, DM, 0, 0}; pg8::StaticOrder S; S.init(NTOK, NQKV, Gg, (int)blockIdx.x, WGM_INPROJ);
          pg8::EpiQKV E{QKV, NQKV, (const float*)(ws + WS_ROPE), (float*)(ws + WS_KMEAN)};
          pg8::gemm_phase<pg8::EpiQKV, pg8::StaticOrder, true, true>(F.lds + RING_OFF, g, S, E); }
#endif
        GRID_BAR();
}

for (int rep_ = 0; rep_ < REP_ATTN; ++rep_) {
        { const att::Tensors T{QKV, OB, (const float*)(ws + WS_LOGF), (const float*)(ws + WS_KMEAN), (float*)(ws + WS_FBIAS)};
#if PH_MOBA
          att::attn_phase<0>((LAS char*)(F.lds + RING_OFF), T, F.vcu, F.G);
#endif
#if PH_FOX
          att::attn_phase<1>((LAS char*)(F.lds + RING_OFF), T, F.vcu, F.G);
#endif
          (void)T; }
        GRID_BAR();
}

#if PH_WO
for (int rep_ = 0; rep_ < REP_WO; ++rep_) {
        { pg8::Gemm g{OB, (const bf16*)(ws + WS_WO) + (size_t)l * DM * DM, NTOK, DM, DM, 0, 0}; pg8::StaticOrder S; S.init(NTOK, DM, F.G, (int)blockIdx.x, WGM_WO);
          LAS float* rs = (LAS float*)(F.lds + RS_OFF);
          { int tid_ = F.tid; asm volatile("" : "+v"(tid_)); pg8::Unit uu; const float* ssq = (const float*)(ws + WS_FBIAS);
            for (int i = 0; i < RS_UNITS; ++i) if (S.next(i, uu) && tid_ < 256) { const f32x4* q = (const f32x4*)(ssq + (size_t)(uu.pm * 256 + tid_) * 16); const f32x4 a0 = q[0], a1 = q[1], a2 = q[2], a3 = q[3];
                const float sm = ((a0[0] + a0[1]) + (a0[2] + a0[3])) + ((a1[0] + a1[1]) + (a1[2] + a1[3])), sf = ((a2[0] + a2[1]) + (a2[2] + a2[3])) + ((a3[0] + a3[1]) + (a3[2] + a3[3]));
                const float rf = 1.0f / sqrtf(sf * (1.f / 1024.f) + EPS), rm = 1.0f / sqrtf(sm * (1.f / 1024.f) + EPS);
                rs[(i * 256 + tid_) * 2] = rm / rf; rs[(i * 256 + tid_) * 2 + 1] = rf; }
            __syncthreads(); }
          pg8::EpiResidB<l == 0, true> E{xin, rep_ ? (bf16*)(ws + WS_YS) : XB, modl + 2 * DM, 1.f, rs};
          pg8::gemm_phase<pg8::EpiResidB<l == 0, true>, pg8::StaticOrder, true, true>(F.lds + RING_OFF, g, S, E); }
#endif
        GRID_BAR();
}
        if (l == 0) {
#if PH_NORM2
for (int rep_ = 0; rep_ < REP_NORM2; ++rep_) {
            norm_phase<2, true>(F, args, XB, inp(ws, I_ffn_norm_g) + l * DM, modl, 3, nullptr, nullptr, H);
#endif
            GRID_BAR();
}
for (int xb_ = 0; xb_ < EXTRA_BARS; ++xb_) GRID_BAR();
#if PH_DUP
for (int rep_ = 0; rep_ < REP_DUP; ++rep_) {
#if DENSE_FP8
            if (conv_split(F.G) && (int)blockIdx.x >= F.G - CONV_CUS_B) p0b<2>(F, args);
            else { const int Gg = conv_split(F.G) ? F.G - CONV_CUS_B : F.G;
              pg8::Gemm g{H, (const bf16*)(ws + WS_WGU), NTOK, NGU, DM / 2, 0, 0}; pg8::StaticOrder S; S.init(NTOK, NGU, Gg, (int)blockIdx.x, WGM_DUP);
              pg8::EpiSwiGLU8 E{(unsigned char*)(ws + WS_ACT), DFF, 1.f / 64.f};
              pg8::gemm_phase<pg8::EpiSwiGLU8, pg8::StaticOrder, true, true, true>(F.lds + RING_OFF, g, S, E); }
#else
            { pg8::Gemm g{H, (const bf16*)(ws + WS_WGU), NTOK, NGU, DM, 0, 0}; pg8::StaticOrder S; S.init(NTOK, NGU, F.G, (int)blockIdx.x, WGM_DUP);
              pg8::EpiSwiGLU E{(bf16*)(ws + WS_ACT), DFF};
              pg8::gemm_phase<pg8::EpiSwiGLU, pg8::StaticOrder, true, true>(F.lds + RING_OFF, g, S, E); }
#endif
#endif
            GRID_BAR();
}
#if PH_DDOWN
for (int rep_ = 0; rep_ < REP_DDOWN; ++rep_) {
#if DENSE_FP8
            { pg8::Gemm g{(const bf16*)(ws + WS_ACT), (const bf16*)(ws + WS_WD), NTOK, DM, DFF / 2, 0, 0}; pg8::StaticOrder S; S.init(NTOK, DM, F.G, (int)blockIdx.x, WGM_DDOWN);
              pg8::EpiResidB<false, false> E{XB, rep_ ? (bf16*)(ws + WS_YS) : XB, modl + 5 * DM, 1.f / 128.f, nullptr};
              pg8::gemm_phase<pg8::EpiResidB<false, false>, pg8::StaticOrder, true, true, true>(F.lds + RING_OFF, g, S, E); }
#else
            { pg8::Gemm g{(const bf16*)(ws + WS_ACT), (const bf16*)(ws + WS_WD), NTOK, DM, DFF, 0, 0}; pg8::StaticOrder S; S.init(NTOK, DM, F.G, (int)blockIdx.x, WGM_DDOWN);
              pg8::EpiResidB<false, false> E{XB, rep_ ? (bf16*)(ws + WS_YS) : XB, modl + 5 * DM, 1.f, nullptr};
              pg8::gemm_phase<pg8::EpiResidB<false, false>, pg8::StaticOrder, true, true>(F.lds + RING_OFF, g, S, E); }
#endif
#endif
            GRID_BAR();
}
        } else {
#if PH_NORM3
for (int rep_ = 0; rep_ < REP_NORM3; ++rep_) {
            norm_phase<1, true>(F, args, XB, inp(ws, I_ffn_norm_g) + l * DM, modl, 3, inp(ws, I_router_w), nullptr, H);
#endif
            GRID_BAR();
}
#if PH_GATHER
for (int rep_ = 0; rep_ < REP_GATHER; ++rep_) {
            moe_gather_phase(F, args);
#endif
            GRID_BAR();
}
            const LAS int* tile_e = (const LAS int*)(F.lds + TILE_E_OFF); const int nM = __builtin_amdgcn_readfirstlane(tile_e[140]);
#if PH_MUP
for (int rep_ = 0; rep_ < REP_MUP; ++rep_) {
            { pg8::Gemm g{(const bf16*)(ws + WS_HS), (const bf16*)(ws + WS_WGU8), MOE_ROWS, NGU, DM / 2, (size_t)NGU * DM, 0}; pg8::MoeOrder S; S.init(nM, NGU, F.G, (int)blockIdx.x, tile_e, WGM_MUP);
              pg8::EpiSwiGLU8 E{(unsigned char*)(ws + WS_ACTM), DFF, 1.f / 64.f};
              pg8::gemm_phase<pg8::EpiSwiGLU8, pg8::MoeOrder, true, true, true>(F.lds + RING_OFF, g, S, E); }
#endif
            GRID_BAR();
}
#if PH_MDOWN
for (int rep_ = 0; rep_ < REP_MDOWN; ++rep_) {
            { const int nR = MOE_SPLIT ? nM % 32 : 0, nF = nM - nR;
              if (nF > 0) { pg8::Gemm g{(const bf16*)(ws + WS_ACTM), (const bf16*)(ws + WS_WD8), MOE_ROWS, DM, DFF / 2, (size_t)DM * DFF, 0}; pg8::MoeOrder S; S.init(nF, DM, F.G, (int)blockIdx.x, tile_e, WGM_MDOWN);
                pg8::EpiBf16S E{(bf16*)(ws + WS_YS), DM, 1.f / 128.f};
                pg8::gemm_phase<pg8::EpiBf16S, pg8::MoeOrder, true, true, true>(F.lds + RING_OFF, g, S, E); }
              if (nR > 0) { const int SS = moe_split_s(nR, F.G);
                pg8::Gemm g{(const bf16*)(ws + WS_ACTM), (const bf16*)(ws + WS_WD8), MOE_ROWS, DM, DFF / 2, (size_t)DM * DFF, 56 / SS};
                pg8::MoeSplitOrder S{nF, nR, SS, F.G, (int)blockIdx.x, (unsigned)(56 / SS) * 128u, tile_e};
                pg8::EpiF32P E{(float*)(ws + WS_YP), nF, nR, 1.f / 128.f};
                pg8::gemm_phase<pg8::EpiF32P, pg8::MoeSplitOrder, true, true, true>(F.lds + RING_OFF, g, S, E); } }
#endif
            GRID_BAR();
}
#if PH_FINAL
for (int rep_ = REP_FINAL - 1; rep_ >= 0; --rep_) {
            final_phase(F, args, XB, modl + 5 * DM, rep_ ? (float*)(ws + WS_ACTM) : args.out);
 if (rep_) GRID_BAR(); }
#endif
        }
#undef GRID_BAR
}
__global__ void __launch_bounds__(NWAVES * 64, 2) mk_fwd(Args args) {
    extern __shared__ __attribute__((aligned(16))) unsigned char lds[];
    Frame F;
    F.lds = (LAS unsigned char*)lds; F.MISC = (volatile LAS unsigned*)(F.lds + MISC_OFF);
    F.tid = threadIdx.x; F.lane = F.tid & 63; F.wave = __builtin_amdgcn_readfirstlane(F.tid >> 6);
    F.G = gridDim.x; { const int bx = blockIdx.x; F.vcu = (F.G % 8 == 0) ? (bx % 8) * (F.G / 8) + bx / 8 : bx; }
    unsigned char* ws = args.ws;
    F.ctl = (gu32*)(ws + WS_CTL);
    for (int u = F.tid; u < (LDS_BYTES - LDSCTL_OFF) / 4; u += NWAVES * 64) ((LAS unsigned*)(F.lds + LDSCTL_OFF))[u] = 0u;
    __syncthreads();
    XcdBarrier bar = xcd_barrier_post((unsigned*)(F.ctl + CW_BAR), F.MISC + 8);
#define GRID_BAR() xcd_barrier(bar)
    bf16* H = (bf16*)(ws + WS_H); bf16* QKV = (bf16*)(ws + WS_QKV); bf16* OB = (bf16*)(ws + WS_O);
    const float* mod = (const float*)(ws + WS_MOD);

#if PH_P0
for (int rep_ = 0; rep_ < REP_P0; ++rep_) {
    p0a(F, args); GRID_BAR();
    p0b<0>(F, args); GRID_BAR();
}
#endif

    layer_body<0>(F, args, bar);
    layer_body<1>(F, args, bar);
}

extern "C" void kernel_launch(void* const* d_in, const int* in_sizes, int n_in, void* d_out, int out_size, void* d_ws, size_t ws_size, hipStream_t stream) {
    static int grid = 0;
    if (grid == 0) {
        if (n_in != 19 || out_size != NTOK * DM || ws_size < WS_END) { fprintf(stderr, "kernel_launch: unexpected shapes (n_in %d out %d ws %zu, need %zu); nothing launched\n", n_in, out_size, ws_size, (size_t)WS_END); grid = -1; return; }
        int dev = 0, cus = 0, per_cu = 0;
        if (hipGetDevice(&dev) != hipSuccess || hipDeviceGetAttribute(&cus, hipDeviceAttributeMultiprocessorCount, dev) != hipSuccess) { grid = -1; return; }
        if (hipFuncSetAttribute((const void*)mk_fwd, hipFuncAttributeMaxDynamicSharedMemorySize, LDS_BYTES) != hipSuccess) { fprintf(stderr, "kernel_launch: hipFuncSetAttribute failed\n"); grid = -1; return; }
        if (hipOccupancyMaxActiveBlocksPerMultiprocessor(&per_cu, (const void*)mk_fwd, NWAVES * 64, LDS_BYTES) != hipSuccess || per_cu < 1) fprintf(stderr, "kernel_launch: note: occupancy query reports %d\n", per_cu);
        (void)hipGetLastError();
        grid = cus;
    }
    if (grid < 0) return;
    if (hipMemsetAsync((char*)d_ws + WS_CTL, 0, CTL_ZERO_BYTES, stream) != hipSuccess) return;
    Args a{};
    for (int i = 0; i < N_IN; ++i) a.in[i] = (const float*)d_in[i];
    a.out = (float*)d_out; a.ws = (unsigned char*)d_ws;
    hipLaunchKernelGGL(mk_fwd, dim3(grid), dim3(NWAVES * 64), LDS_BYTES, stream, a);
}
```

```cpp
#include <hip/hip_runtime.h>
#include <cstdio>
#include <cstdint>
#include <cmath>
namespace pg8 {
#define PG8_LAS __attribute__((address_space(3)))
typedef unsigned short bf16_t;
typedef short bf16x8 __attribute__((ext_vector_type(8)));
typedef float f32x4 __attribute__((ext_vector_type(4)));
typedef unsigned u32x4 __attribute__((ext_vector_type(4)));
constexpr int BM = 256, BK = 64, HALF = 128, HTB = HALF * BK * 2  , STAGE_BYTES = 8 * HTB, NXCD = 8, WGM = 8;

__host__ __device__ __forceinline__ int lds_byte(int r, int c) { const int st = (r >> 4) * 2 + (c >> 5), rr = r & 15, cc = c & 31, ob = rr * 64 + cc * 2; return st * 1024 + (ob ^ (((ob >> 9) & 1) << 5)); }
__host__ __device__ __forceinline__ void stage_rc(int b, int& R, int& C) { const int st = b / 1024, sb = b % 1024, swz = sb ^ (((sb >> 9) & 1) << 5); R = (st >> 1) * 16 + swz / 64; C = (st & 1) * 32 + (swz % 64) / 2; }
__host__ __device__ __forceinline__ int perm32(int rho) { const int n = rho >> 4, i = rho & 15; return 8 * (i >> 2) + 4 * n + (i & 3); }

struct Unit { int pm, pn, be, idx; unsigned koff; };
struct Gemm { const bf16_t* A; const bf16_t* Bt; int M, N, K; size_t bstride; int nt; };

struct StaticOrder {
    int nM, nN, nwg, G, c, wgm;
    __host__ __device__ void init(int M, int N, int G_, int c_, int wgm_ = WGM) { nM = M / BM; nN = N / BM; nwg = nM * nN; G = G_; c = c_; wgm = wgm_; }
    __host__ __device__ bool next(int i, Unit& u) const {
        const long L = (long)i * G + c; if (L >= nwg) return false;
        int wgid = (int)L; { const int q = nwg / NXCD, r = nwg % NXCD, xcd = wgid % NXCD, off = wgid / NXCD; wgid = (xcd < r ? xcd * (q + 1) : r * (q + 1) + (xcd - r) * q) + off; }
        const int nig = wgm * nN, gid = wgid / nig, fm = gid * wgm, gsz = (nM - fm) < wgm ? (nM - fm) : wgm;
        u.pm = fm + ((wgid % nig) % gsz); u.pn = (wgid % nig) / gsz; u.be = 0; u.idx = i; u.koff = 0u; return true;
    }
    __device__ __forceinline__ void a_ready(const Unit&) const {}
    __device__ __forceinline__ void done(const Unit&) const {}
};

__device__ __forceinline__ unsigned cvt_pk_bf16(float lo, float hi) { unsigned r; asm volatile("v_cvt_pk_bf16_f32 %0, %1, %2" : "=v"(r) : "v"(lo), "v"(hi)); return r; }
typedef float f32x2 __attribute__((ext_vector_type(2)));
typedef int i32x8 __attribute__((ext_vector_type(8)));
typedef int i32x4v __attribute__((ext_vector_type(4)));
__device__ __forceinline__ f32x4 mfma_fp8_128(bf16x8 b0, bf16x8 b1, bf16x8 a0, bf16x8 a1, f32x4 c) {
    const i32x4v bl = __builtin_bit_cast(i32x4v, b0), bh = __builtin_bit_cast(i32x4v, b1), al = __builtin_bit_cast(i32x4v, a0), ah = __builtin_bit_cast(i32x4v, a1);
    const i32x8 B = {bl[0], bl[1], bl[2], bl[3], bh[0], bh[1], bh[2], bh[3]}, A = {al[0], al[1], al[2], al[3], ah[0], ah[1], ah[2], ah[3]};
    asm volatile("v_mfma_f32_16x16x128_f8f6f4 %0, %1, %2, %0" : "+v"(c) : "v"(B), "v"(A));
    return c;
}
__device__ __forceinline__ unsigned pk_fp8x4(float a, float b, float c, float d) { int w = 0; w = __builtin_amdgcn_cvt_pk_fp8_f32(a, b, w, false); w = __builtin_amdgcn_cvt_pk_fp8_f32(c, d, w, true); return (unsigned)w; }

struct EpiQKV {
    static constexpr bool PERM = true, AFTER_DRAIN = false, HAS_MID = false;
    bf16_t* O; int ldc; const float* ropeT; float* ksum;
    __device__ __forceinline__ void operator()(const f32x4 (&acc)[2][2][4][2], const Unit& u, int wr, int wc, int fr, int fq) const {
        const int row0 = u.pm * BM + wr * 64 + fr, col0 = u.pn * BM + wc * 32 + 8 * fq; const bool rope = u.pn < 8, ktile = u.pn >= 4 && u.pn < 8;
        float cs[16];
#pragma unroll
        for (int i = 0; i < 16; ++i) cs[i] = 0.f;
#pragma unroll
        for (int ai = 0; ai < 2; ++ai)
#pragma unroll
            for (int m = 0; m < 4; ++m) { const int row = row0 + ai * HALF + m * 16; bf16_t* rowp = O + (size_t)row * ldc + col0;
                f32x4 c4 = {1.f, 1.f, 1.f, 1.f}, s4 = {0.f, 0.f, 0.f, 0.f};
                if (rope) { const float* rt = ropeT + ((size_t)(row & 4095) * 16 + (wc * 4 + fq)) * 8; c4 = *(const f32x4*)rt; s4 = *(const f32x4*)(rt + 4); }
#pragma unroll
                for (int bj = 0; bj < 2; ++bj) { f32x4 v0 = acc[ai][bj][m][0], v1 = acc[ai][bj][m][1];
                    if (rope) { const f32x4 t1 = v0, t2 = v1; v0 = t1 * c4 - t2 * s4; v1 = t2 * c4 + t1 * s4; }
                    if (ktile) {
#pragma unroll
                        for (int j = 0; j < 4; ++j) { cs[bj * 8 + j] += v0[j]; cs[bj * 8 + 4 + j] += v1[j]; } }
                    u32x4 w; w.x = cvt_pk_bf16(v0[0], v0[1]); w.y = cvt_pk_bf16(v0[2], v0[3]); w.z = cvt_pk_bf16(v1[0], v1[1]); w.w = cvt_pk_bf16(v1[2], v1[3]);
                    *(u32x4*)(rowp + bj * HALF) = w; } }
        if (ktile) {
            float a8[8], a4[4], a2[2], a1;
            const bool b3 = (fr & 8) != 0, b2 = (fr & 4) != 0, b1 = (fr & 2) != 0, b0 = (fr & 1) != 0;
#pragma unroll
            for (int i = 0; i < 8; ++i) { const float send = b3 ? cs[i] : cs[i + 8], keep = b3 ? cs[i + 8] : cs[i]; a8[i] = keep + __shfl_xor(send, 8); }
#pragma unroll
            for (int i = 0; i < 4; ++i) { const float send = b2 ? a8[i] : a8[i + 4], keep = b2 ? a8[i + 4] : a8[i]; a4[i] = keep + __shfl_xor(send, 4); }
#pragma unroll
            for (int i = 0; i < 2; ++i) { const float send = b1 ? a4[i] : a4[i + 2], keep = b1 ? a4[i + 2] : a4[i]; a2[i] = keep + __shfl_xor(send, 2); }
            { const float send = b0 ? a2[0] : a2[1], keep = b0 ? a2[1] : a2[0]; a1 = keep + __shfl_xor(send, 1); }
            const int bj = fr >> 3, n = (fr >> 2) & 1, j = fr & 3;
            const int hd = (u.pn - 4) * 2 + bj, dcol = wc * 32 + 8 * fq + 4 * n + j;
            float* dst = ksum + (((size_t)(u.pm >> 4) * 8 + hd) * 16 + (u.pm & 15)) * 128 + dcol;
            __hip_atomic_fetch_add(dst, a1, __ATOMIC_RELAXED, __HIP_MEMORY_SCOPE_AGENT);
        }
    }
};
struct EpiResid {
    static constexpr bool PERM = false, AFTER_DRAIN = false, HAS_MID = false;
    const float* xin; float* out; const float* gate; float sc;
    __device__ __forceinline__ void operator()(const f32x4 (&acc)[2][2][4][2], const Unit& u, int wr, int wc, int fr, int fq) const {
        const int row0 = u.pm * BM + wr * 64 + fr, col0 = u.pn * BM + wc * 32 + 4 * fq; const float* gp = gate + (size_t)(u.pm >> 4) * 12288 + col0;
        f32x4 gv[2][2];
#pragma unroll
        for (int bj = 0; bj < 2; ++bj)
#pragma unroll
            for (int n = 0; n < 2; ++n) gv[bj][n] = *(const f32x4*)(gp + bj * HALF + n * 16) * sc;
#pragma unroll
        for (int ai = 0; ai < 2; ++ai) { f32x4 pre[4][2][2];
#pragma unroll
            for (int m = 0; m < 4; ++m) { const size_t off = (size_t)(row0 + ai * HALF + m * 16) * 2048 + col0;
#pragma unroll
                for (int bj = 0; bj < 2; ++bj)
#pragma unroll
                    for (int n = 0; n < 2; ++n) pre[m][bj][n] = *(const f32x4*)(xin + off + bj * HALF + n * 16); }
            __builtin_amdgcn_sched_barrier(0);
#pragma unroll
            for (int m = 0; m < 4; ++m) { const size_t off = (size_t)(row0 + ai * HALF + m * 16) * 2048 + col0;
#pragma unroll
                for (int bj = 0; bj < 2; ++bj)
#pragma unroll
                    for (int n = 0; n < 2; ++n) *(f32x4*)(out + off + bj * HALF + n * 16) = pre[m][bj][n] + gv[bj][n] * acc[ai][bj][m][n]; }
            __builtin_amdgcn_sched_barrier(0); }
    }
};
struct EpiResidN {
    static constexpr bool PERM = false, AFTER_DRAIN = false, HAS_MID = true;
    const float* xin; float* out; const float* gate; const PG8_LAS float* rs;
    __device__ __forceinline__ void mid(f32x4 (&acc)[2][2][4][2], const Unit& u, int wr, int wc, int fr, int fq) const {
        const PG8_LAS float* r = rs + (u.idx * 256 + wr * 64 + fr) * 2;
#pragma unroll
        for (int ai = 0; ai < 2; ++ai)
#pragma unroll
            for (int m = 0; m < 4; ++m) { const float ratio = r[(ai * HALF + m * 16) * 2];
#pragma unroll
                for (int bj = 0; bj < 2; ++bj)
#pragma unroll
                    for (int n = 0; n < 2; ++n) acc[ai][bj][m][n] = acc[ai][bj][m][n] * ratio; }
    }
    __device__ __forceinline__ void operator()(const f32x4 (&acc)[2][2][4][2], const Unit& u, int wr, int wc, int fr, int fq) const {
        const int row0 = u.pm * BM + wr * 64 + fr, col0 = u.pn * BM + wc * 32 + 4 * fq; const float* gp = gate + (size_t)(u.pm >> 4) * 12288 + col0;
        const PG8_LAS float* r = rs + (u.idx * 256 + wr * 64 + fr) * 2 + 1;
        f32x4 gv[2][2];
#pragma unroll
        for (int bj = 0; bj < 2; ++bj)
#pragma unroll
            for (int n = 0; n < 2; ++n) gv[bj][n] = *(const f32x4*)(gp + bj * HALF + n * 16);
#pragma unroll
        for (int ai = 0; ai < 2; ++ai) { f32x4 pre[4][2][2];
#pragma unroll
            for (int m = 0; m < 4; ++m) { const size_t off = (size_t)(row0 + ai * HALF + m * 16) * 2048 + col0;
#pragma unroll
                for (int bj = 0; bj < 2; ++bj)
#pragma unroll
                    for (int n = 0; n < 2; ++n) pre[m][bj][n] = *(const f32x4*)(xin + off + bj * HALF + n * 16); }
            __builtin_amdgcn_sched_barrier(0);
#pragma unroll
            for (int m = 0; m < 4; ++m) { const size_t off = (size_t)(row0 + ai * HALF + m * 16) * 2048 + col0; const float rf = r[(ai * HALF + m * 16) * 2];
#pragma unroll
                for (int bj = 0; bj < 2; ++bj)
#pragma unroll
                    for (int n = 0; n < 2; ++n) *(f32x4*)(out + off + bj * HALF + n * 16) = pre[m][bj][n] + gv[bj][n] * (acc[ai][bj][m][n] * rf); }
            __builtin_amdgcn_sched_barrier(0); }
    }
};
template <bool XF32, bool NRM>
struct EpiResidB {
    static constexpr bool PERM = true, AFTER_DRAIN = false, HAS_MID = NRM;
    const void* xin; bf16_t* out; const float* gate; float sc; const PG8_LAS float* rs;
    __device__ __forceinline__ void mid(f32x4 (&acc)[2][2][4][2], const Unit& u, int wr, int wc, int fr, int fq) const {
        const PG8_LAS float* r = rs + (u.idx * 256 + wr * 64 + fr) * 2;
#pragma unroll
        for (int ai = 0; ai < 2; ++ai)
#pragma unroll
            for (int m = 0; m < 4; ++m) { const float ratio = r[(ai * HALF + m * 16) * 2];
#pragma unroll
                for (int bj = 0; bj < 2; ++bj)
#pragma unroll
                    for (int n = 0; n < 2; ++n) acc[ai][bj][m][n] = acc[ai][bj][m][n] * ratio; }
    }
    __device__ __forceinline__ void operator()(const f32x4 (&acc)[2][2][4][2], const Unit& u, int wr, int wc, int fr, int fq) const {
        const int row0 = u.pm * BM + wr * 64 + fr, col0 = u.pn * BM + wc * 32 + 8 * fq; const float* gp = gate + (size_t)(u.pm >> 4) * 12288 + col0;
        const PG8_LAS float* r = rs + (u.idx * 256 + wr * 64 + fr) * 2 + 1;
        f32x4 gv[2][2];
#pragma unroll
        for (int bj = 0; bj < 2; ++bj)
#pragma unroll
            for (int n = 0; n < 2; ++n) gv[bj][n] = *(const f32x4*)(gp + bj * HALF + n * 4) * sc;
#pragma unroll
        for (int ai = 0; ai < 2; ++ai) { f32x4 pre[4][2][2]; u32x4 praw[4][2];
#pragma unroll
            for (int m = 0; m < 4; ++m) { const size_t off = (size_t)(row0 + ai * HALF + m * 16) * 2048 + col0;
#pragma unroll
                for (int bj = 0; bj < 2; ++bj) {
                    if (XF32) { pre[m][bj][0] = *(const f32x4*)((const float*)xin + off + bj * HALF); pre[m][bj][1] = *(const f32x4*)((const float*)xin + off + bj * HALF + 4); }
                    else praw[m][bj] = *(const u32x4*)((const bf16_t*)xin + off + bj * HALF); } }
            __builtin_amdgcn_sched_barrier(0);
#pragma unroll
            for (int m = 0; m < 4; ++m) { const size_t off = (size_t)(row0 + ai * HALF + m * 16) * 2048 + col0; float rf = 1.f; if (NRM) rf = r[(ai * HALF + m * 16) * 2];
#pragma unroll
                for (int bj = 0; bj < 2; ++bj) { f32x4 x0, x1, v0, v1;
                    if (XF32) { x0 = pre[m][bj][0]; x1 = pre[m][bj][1]; }
                    else { const u32x4 w = praw[m][bj];
                        x0 = (f32x4){__builtin_bit_cast(float, w.x << 16), __builtin_bit_cast(float, w.x & 0xffff0000u), __builtin_bit_cast(float, w.y << 16), __builtin_bit_cast(float, w.y & 0xffff0000u)};
                        x1 = (f32x4){__builtin_bit_cast(float, w.z << 16), __builtin_bit_cast(float, w.z & 0xffff0000u), __builtin_bit_cast(float, w.w << 16), __builtin_bit_cast(float, w.w & 0xffff0000u)}; }
                    if (NRM) { v0 = x0 + gv[bj][0] * (acc[ai][bj][m][0] * rf); v1 = x1 + gv[bj][1] * (acc[ai][bj][m][1] * rf); }
                    else { v0 = x0 + gv[bj][0] * acc[ai][bj][m][0]; v1 = x1 + gv[bj][1] * acc[ai][bj][m][1]; }
                    u32x4 w; w.x = cvt_pk_bf16(v0[0], v0[1]); w.y = cvt_pk_bf16(v0[2], v0[3]); w.z = cvt_pk_bf16(v1[0], v1[1]); w.w = cvt_pk_bf16(v1[2], v1[3]);
                    *(u32x4*)(out + off + bj * HALF) = w; } }
            __builtin_amdgcn_sched_barrier(0); }
    }
};
struct EpiSwiGLU {
    static constexpr bool PERM = true, AFTER_DRAIN = false, HAS_MID = false;
    bf16_t* O; int ldc;
    __device__ __forceinline__ void operator()(const f32x4 (&acc)[2][2][4][2], const Unit& u, int wr, int wc, int fr, int fq) const {
        const int row0 = u.pm * BM + wr * 64 + fr, col0 = u.pn * HALF + wc * 32 + 8 * fq;
#pragma unroll
        for (int ai = 0; ai < 2; ++ai)
#pragma unroll
            for (int m = 0; m < 4; ++m) { bf16_t* rowp = O + (size_t)(row0 + ai * HALF + m * 16) * ldc + col0; float a[8];
#pragma unroll
                for (int n = 0; n < 2; ++n)
#pragma unroll
                    for (int j = 0; j < 4; ++j) { const float g = acc[ai][0][m][n][j], up = acc[ai][1][m][n][j];
                        a[n * 4 + j] = g * __builtin_amdgcn_rcpf(1.0f + __builtin_amdgcn_exp2f(-1.4426950408889634f * g)) * up; }
                u32x4 w; w.x = cvt_pk_bf16(a[0], a[1]); w.y = cvt_pk_bf16(a[2], a[3]); w.z = cvt_pk_bf16(a[4], a[5]); w.w = cvt_pk_bf16(a[6], a[7]);
                *(u32x4*)rowp = w; }
    }
};
struct EpiSwiGLU8 {
    static constexpr bool PERM = true, AFTER_DRAIN = false, HAS_MID = false;
    unsigned char* O; int ldc; float sc;
    __device__ __forceinline__ void operator()(const f32x4 (&acc)[2][2][4][2], const Unit& u, int wr, int wc, int fr, int fq) const {
        const int row0 = u.pm * BM + wr * 64 + fr, col0 = u.pn * HALF + wc * 32 + 8 * fq; const float S = 1.0f / (sc * sc);
#pragma unroll
        for (int ai = 0; ai < 2; ++ai)
#pragma unroll
            for (int m = 0; m < 4; ++m) { unsigned char* rowp = O + (size_t)(row0 + ai * HALF + m * 16) * ldc + col0; float a[8];
#pragma unroll
                for (int n = 0; n < 2; ++n)
#pragma unroll
                    for (int j = 0; j < 4; j += 2) {
                        typedef float f32x2 __attribute__((ext_vector_type(2)));
                        const f32x2 g = {acc[ai][0][m][n][j], acc[ai][0][m][n][j + 1]}, up = {acc[ai][1][m][n][j], acc[ai][1][m][n][j + 1]};
                        const f32x2 t = g * (-1.4426950408889634f * sc); f32x2 e; e.x = __builtin_amdgcn_exp2f(t.x); e.y = __builtin_amdgcn_exp2f(t.y);
                        const f32x2 d = e * S + S; f32x2 r; r.x = __builtin_amdgcn_rcpf(d.x); r.y = __builtin_amdgcn_rcpf(d.y);
                        const f32x2 o = (g * up) * r; a[n * 4 + j] = o.x; a[n * 4 + j + 1] = o.y; }
                typedef unsigned u32x2 __attribute__((ext_vector_type(2)));
                u32x2 w; w.x = pk_fp8x4(a[0], a[1], a[2], a[3]); w.y = pk_fp8x4(a[4], a[5], a[6], a[7]);
                *(u32x2*)rowp = w; }
    }
};
struct EpiBf16S {
    static constexpr bool PERM = true, AFTER_DRAIN = false, HAS_MID = false;
    bf16_t* O; int ldc; float sc;
    __device__ __forceinline__ void operator()(const f32x4 (&acc)[2][2][4][2], const Unit& u, int wr, int wc, int fr, int fq) const {
        const int row0 = u.pm * BM + wr * 64 + fr, col0 = u.pn * BM + wc * 32 + 8 * fq;
#pragma unroll
        for (int ai = 0; ai < 2; ++ai)
#pragma unroll
            for (int m = 0; m < 4; ++m) { bf16_t* rowp = O + (size_t)(row0 + ai * HALF + m * 16) * ldc + col0;
#pragma unroll
                for (int bj = 0; bj < 2; ++bj) { const f32x4 v0 = acc[ai][bj][m][0] * sc, v1 = acc[ai][bj][m][1] * sc;
                    u32x4 w; w.x = cvt_pk_bf16(v0[0], v0[1]); w.y = cvt_pk_bf16(v0[2], v0[3]); w.z = cvt_pk_bf16(v1[0], v1[1]); w.w = cvt_pk_bf16(v1[2], v1[3]);
                    *(u32x4*)(rowp + bj * HALF) = w; } }
    }
};
struct EpiF32 {
    static constexpr bool PERM = false, AFTER_DRAIN = false, HAS_MID = false;
    float* out; float sc;
    __device__ __forceinline__ void operator()(const f32x4 (&acc)[2][2][4][2], const Unit& u, int wr, int wc, int fr, int fq) const {
        const int row0 = u.pm * BM + wr * 64 + fr, col0 = u.pn * BM + wc * 32 + 4 * fq;
#pragma unroll
        for (int ai = 0; ai < 2; ++ai)
#pragma unroll
            for (int m = 0; m < 4; ++m) { const size_t off = (size_t)(row0 + ai * HALF + m * 16) * 2048 + col0;
#pragma unroll
                for (int bj = 0; bj < 2; ++bj)
#pragma unroll
                    for (int n = 0; n < 2; ++n) *(f32x4*)(out + off + bj * HALF + n * 16) = acc[ai][bj][m][n] * sc; }
    }
};
struct MoeOrder {
    int nM, nN, nwg, G, c, wgm; const PG8_LAS int* tile_e;
    __device__ void init(int nM_, int N, int G_, int c_, const PG8_LAS int* te, int wgm_ = WGM) { nM = nM_; nN = N / BM; nwg = nM * nN; G = G_; c = c_; tile_e = te; wgm = wgm_; }
    __device__ bool next(int i, Unit& u) const {
        const long L = (long)i * G + c; if (L >= nwg) return false;
        int wgid = (int)L; { const int q = nwg / NXCD, r = nwg % NXCD, xcd = wgid % NXCD, off = wgid / NXCD; wgid = (xcd < r ? xcd * (q + 1) : r * (q + 1) + (xcd - r) * q) + off; }
        const int nig = wgm * nN, gid = wgid / nig, fm = gid * wgm, gsz = (nM - fm) < wgm ? (nM - fm) : wgm;
        u.pm = fm + ((wgid % nig) % gsz); u.pn = (wgid % nig) / gsz; u.be = __builtin_amdgcn_readfirstlane(tile_e[u.pm]); u.idx = i; u.koff = 0u; return true;
    }
    __device__ __forceinline__ void a_ready(const Unit&) const {}
    __device__ __forceinline__ void done(const Unit&) const {}
};

struct MoeSplitOrder {
    int nF, nR, S, G, c; unsigned slice_bytes; const PG8_LAS int* tile_e;
    __device__ bool next(int i, Unit& u) const {
        const int L = i * G + c; if (L >= nR * 8 * S) return false;
        const int t = L >> 3, ks = t / nR; u.pn = L & 7; u.pm = nF + (t - ks * nR); u.be = __builtin_amdgcn_readfirstlane(tile_e[u.pm]); u.idx = ks; u.koff = (unsigned)ks * slice_bytes; return true;
    }
    __device__ __forceinline__ void a_ready(const Unit&) const {}
    __device__ __forceinline__ void done(const Unit&) const {}
};
struct EpiF32P {
    static constexpr bool PERM = false, AFTER_DRAIN = false, HAS_MID = false;
    float* out; int nF, nR; float sc;
    __device__ __forceinline__ void operator()(const f32x4 (&acc)[2][2][4][2], const Unit& u, int wr, int wc, int fr, int fq) const {
        const int row0 = (u.idx * nR + (u.pm - nF)) * BM + wr * 64 + fr, col0 = u.pn * BM + wc * 32 + 4 * fq;
#pragma unroll
        for (int ai = 0; ai < 2; ++ai)
#pragma unroll
            for (int m = 0; m < 4; ++m) { const size_t off = (size_t)(row0 + ai * HALF + m * 16) * 2048 + col0;
#pragma unroll
                for (int bj = 0; bj < 2; ++bj)
#pragma unroll
                    for (int n = 0; n < 2; ++n) *(f32x4*)(out + off + bj * HALF + n * 16) = acc[ai][bj][m][n] * sc; }
    }
};
template <class Epi, class Sched, bool ALIGN_EPI = false, bool SP2 = false, bool FP8 = false>
__device__ __forceinline__ void gemm_phase(PG8_LAS unsigned char* lds, const Gemm g, const Sched& S, const Epi& E) {
    int tid_ = threadIdx.x; asm volatile("" : "+v"(tid_));
    const int tid = tid_, wid = __builtin_amdgcn_readfirstlane(tid >> 6), lane = tid & 63, wr = wid >> 2, wc = wid & 3, fr = lane & 15, fq = lane >> 4;
    const int K = g.K, nt = g.nt ? g.nt : K / BK;
    unsigned voffA[2], voffB[2];
#pragma unroll
    for (int i = 0; i < 2; ++i) { int R, C; stage_rc(tid * 16 + i * 8192, R, C); const int Rb = Epi::PERM ? ((R & ~31) + perm32(R & 31)) : R;
        voffA[i] = (unsigned)(R * K + C) * 2u; voffB[i] = (unsigned)(Rb * K + C) * 2u; }
    const size_t kstep = (size_t)(BK * 2);
    const size_t hstep = (size_t)HALF * K * 2;
    const size_t tstep = 2 * hstep;
    const unsigned ldsw = (unsigned)wid * 1024u;
    const int aoff = lds_byte(wr * 64 + fr, fq * 8), boff = lds_byte(wc * 32 + fr, fq * 8);
#define PG8_SA(b, h) (((b) * 2 + (h)) * HTB)
#define PG8_SB(b, h) ((4 + (b) * 2 + (h)) * HTB)
#define PG8_STAGE(bufoff, gbase, voff) do { _Pragma("unroll") for (int _i = 0; _i < 2; ++_i) \
        __builtin_amdgcn_global_load_lds((const unsigned*)((const char*)(gbase) + (voff)[_i]), (PG8_LAS unsigned*)(lds + (bufoff) + ldsw + _i * 8192), 16, 0, 0); } while (0)
#define PG8_LDA(dst, b, h) do { _Pragma("unroll") for (int m = 0; m < 4; ++m) _Pragma("unroll") for (int k = 0; k < 2; ++k) dst[m][k] = *(const PG8_LAS bf16x8*)(lds + PG8_SA(b, h) + aoff + m * 2048 + k * 1024); } while (0)
#define PG8_LDB(dst, b, h) do { _Pragma("unroll") for (int n = 0; n < 2; ++n) _Pragma("unroll") for (int k = 0; k < 2; ++k) dst[n][k] = *(const PG8_LAS bf16x8*)(lds + PG8_SB(b, h) + boff + n * 2048 + k * 1024); } while (0)
#define PG8_MMA(ai, bj, At, Bt) do { __builtin_amdgcn_s_setprio(1); _Pragma("unroll") for (int m = 0; m < 4; ++m) _Pragma("unroll") for (int n = 0; n < 2; ++n) { \
        if constexpr (FP8) acc[ai][bj][m][n] = mfma_fp8_128(Bt[n][0], Bt[n][1], At[m][0], At[m][1], acc[ai][bj][m][n]); \
        else { _Pragma("unroll") for (int k = 0; k < 2; ++k) acc[ai][bj][m][n] = __builtin_amdgcn_mfma_f32_16x16x32_bf16(Bt[n][k], At[m][k], acc[ai][bj][m][n], 0, 0, 0); } } \
        __builtin_amdgcn_s_setprio(0); } while (0)
#define PG8_WAIT_V(n) asm volatile("s_waitcnt vmcnt(" #n ")" ::: "memory")
#define PG8_WAIT_L(n) asm volatile("s_waitcnt lgkmcnt(" #n ")" ::: "memory")
#define PG8_BAR __builtin_amdgcn_s_barrier()
#define PG8_SCHED __builtin_amdgcn_sched_barrier(0)
    Unit cur, nxt; int ui = 0;
    if (!S.next(0, cur)) return;
    f32x4 acc[2][2][4][2];
#pragma unroll
    for (int a = 0; a < 2; ++a)
#pragma unroll
        for (int b = 0; b < 2; ++b)
#pragma unroll
            for (int m = 0; m < 4; ++m)
#pragma unroll
                for (int n = 0; n < 2; ++n) acc[a][b][m][n] = (f32x4){0.f, 0.f, 0.f, 0.f};
    bf16x8 At[4][2], B0[2][2], B1[2][2];
    const char* cA = (const char*)g.A + (size_t)cur.pm * tstep + cur.koff; const char* cB = (const char*)g.Bt + (size_t)cur.be * g.bstride + (size_t)cur.pn * tstep + cur.koff;
    S.a_ready(cur);
    if constexpr (SP2) {
        PG8_STAGE(PG8_SB(0, 0), cB, voffB); PG8_STAGE(PG8_SB(0, 1), cB + hstep, voffB); PG8_STAGE(PG8_SA(0, 0), cA, voffA); PG8_STAGE(PG8_SA(0, 1), cA + hstep, voffA);
        if (wr == 1) PG8_BAR;
        PG8_WAIT_V(2); PG8_BAR;
        PG8_STAGE(PG8_SB(1, 0), cB + kstep, voffB); PG8_STAGE(PG8_SA(1, 0), cA + kstep, voffA); PG8_STAGE(PG8_SB(1, 1), cB + hstep + kstep, voffB);
        PG8_WAIT_V(6); PG8_BAR;
    } else {
        PG8_STAGE(PG8_SB(0, 0), cB, voffB); PG8_STAGE(PG8_SA(0, 0), cA, voffA); PG8_STAGE(PG8_SB(0, 1), cB + hstep, voffB); PG8_STAGE(PG8_SA(0, 1), cA + hstep, voffA);
        if (wr == 1) PG8_BAR;
        PG8_WAIT_V(4); PG8_BAR;
        PG8_STAGE(PG8_SB(1, 0), cB + kstep, voffB); PG8_STAGE(PG8_SA(1, 0), cA + kstep, voffA); PG8_STAGE(PG8_SB(1, 1), cB + hstep + kstep, voffB);
        PG8_WAIT_V(6); PG8_BAR;
    }
    for (;;) {
        const bool has_next = S.next(ui + 1, nxt);
        const char* nA = has_next ? (const char*)g.A + (size_t)nxt.pm * tstep + nxt.koff : cA; const char* nB = has_next ? (const char*)g.Bt + (size_t)nxt.be * g.bstride + (size_t)nxt.pn * tstep + nxt.koff : cB;
        for (int t = 0; t < nt; t += 2) {
            if constexpr (Epi::HAS_MID) { if (t == nt / 2) E.mid(acc, cur, wr, wc, fr, fq); }
            const bool last = (t == nt - 2);
            const char* a1 = cA + (size_t)(t + 1) * kstep;
            const char* a2 = last ? nA : cA + (size_t)(t + 2) * kstep; const char* b2 = last ? nB : cB + (size_t)(t + 2) * kstep;
            const char* a3 = a2 + kstep; const char* b3 = b2 + kstep;
            if (last && has_next) S.a_ready(nxt);
            if constexpr (SP2) {
            PG8_LDB(B0, 0, 0); PG8_LDB(B1, 0, 1); PG8_SCHED; PG8_LDA(At, 0, 0); PG8_STAGE(PG8_SA(1, 1), a1 + hstep, voffA);
            PG8_WAIT_V(8); PG8_WAIT_L(0); PG8_BAR; PG8_MMA(0, 0, At, B0); PG8_MMA(0, 1, At, B1); PG8_BAR; PG8_SCHED;
            PG8_LDA(At, 0, 1); PG8_STAGE(PG8_SB(0, 0), b2, voffB); PG8_STAGE(PG8_SB(0, 1), b2 + hstep, voffB); PG8_STAGE(PG8_SA(0, 0), a2, voffA);
            PG8_WAIT_V(8); PG8_WAIT_L(0); PG8_BAR; PG8_MMA(1, 0, At, B0); PG8_MMA(1, 1, At, B1); PG8_BAR; PG8_SCHED;
            PG8_LDB(B0, 1, 0); PG8_LDB(B1, 1, 1); PG8_SCHED; PG8_LDA(At, 1, 0); PG8_STAGE(PG8_SA(0, 1), a2 + hstep, voffA);
            PG8_WAIT_V(8); PG8_WAIT_L(0); PG8_BAR; PG8_MMA(0, 0, At, B0); PG8_MMA(0, 1, At, B1); PG8_BAR; PG8_SCHED;
            PG8_LDA(At, 1, 1); PG8_STAGE(PG8_SB(1, 0), b3, voffB); PG8_STAGE(PG8_SB(1, 1), b3 + hstep, voffB); PG8_STAGE(PG8_SA(1, 0), a3, voffA);
            PG8_WAIT_V(8); PG8_WAIT_L(0); PG8_BAR; PG8_MMA(1, 0, At, B0); PG8_MMA(1, 1, At, B1); PG8_BAR; PG8_SCHED;
            } else {
            PG8_LDB(B0, 0, 0); PG8_SCHED; PG8_LDA(At, 0, 0); PG8_STAGE(PG8_SA(1, 1), a1 + hstep, voffA);
            PG8_WAIT_L(8); PG8_BAR; PG8_WAIT_L(0); PG8_MMA(0, 0, At, B0); PG8_BAR; PG8_SCHED;
            PG8_LDB(B1, 0, 1); PG8_STAGE(PG8_SB(0, 0), b2, voffB);
            PG8_BAR; PG8_WAIT_L(0); PG8_MMA(0, 1, At, B1); PG8_BAR;
            PG8_LDA(At, 0, 1); PG8_STAGE(PG8_SA(0, 0), a2, voffA);
            PG8_BAR; PG8_WAIT_L(0); PG8_MMA(1, 0, At, B0); PG8_BAR; PG8_SCHED;
            PG8_STAGE(PG8_SB(0, 1), b2 + hstep, voffB);
            PG8_WAIT_V(6); PG8_BAR; PG8_MMA(1, 1, At, B1); PG8_BAR;
            PG8_LDB(B0, 1, 0); PG8_SCHED; PG8_LDA(At, 1, 0); PG8_STAGE(PG8_SA(0, 1), a2 + hstep, voffA);
            PG8_WAIT_L(8); PG8_BAR; PG8_WAIT_L(0); PG8_MMA(0, 0, At, B0); PG8_BAR; PG8_SCHED;
            PG8_LDB(B1, 1, 1); PG8_STAGE(PG8_SB(1, 0), b3, voffB);
            PG8_BAR; PG8_WAIT_L(0); PG8_MMA(0, 1, At, B1); PG8_BAR;
            PG8_LDA(At, 1, 1); PG8_STAGE(PG8_SA(1, 0), a3, voffA);
            PG8_BAR; PG8_WAIT_L(0); PG8_MMA(1, 0, At, B0); PG8_BAR; PG8_SCHED;
            PG8_STAGE(PG8_SB(1, 1), b3 + hstep, voffB);
            PG8_WAIT_V(6); PG8_BAR; PG8_MMA(1, 1, At, B1); PG8_BAR;
            }
        }
        if constexpr (ALIGN_EPI) { if (wr == 0) PG8_BAR; }
        if constexpr (FP8) {
            asm volatile("s_nop 15\n\ts_nop 15" : "+v"(acc[0][0][0][0]), "+v"(acc[0][0][0][1]), "+v"(acc[0][0][1][0]), "+v"(acc[0][0][1][1]), "+v"(acc[0][0][2][0]), "+v"(acc[0][0][2][1]), "+v"(acc[0][0][3][0]), "+v"(acc[0][0][3][1]));
            asm volatile("" : "+v"(acc[0][1][0][0]), "+v"(acc[0][1][0][1]), "+v"(acc[0][1][1][0]), "+v"(acc[0][1][1][1]), "+v"(acc[0][1][2][0]), "+v"(acc[0][1][2][1]), "+v"(acc[0][1][3][0]), "+v"(acc[0][1][3][1]));
            asm volatile("" : "+v"(acc[1][0][0][0]), "+v"(acc[1][0][0][1]), "+v"(acc[1][0][1][0]), "+v"(acc[1][0][1][1]), "+v"(acc[1][0][2][0]), "+v"(acc[1][0][2][1]), "+v"(acc[1][0][3][0]), "+v"(acc[1][0][3][1]));
            asm volatile("" : "+v"(acc[1][1][0][0]), "+v"(acc[1][1][0][1]), "+v"(acc[1][1][1][0]), "+v"(acc[1][1][1][1]), "+v"(acc[1][1][2][0]), "+v"(acc[1][1][2][1]), "+v"(acc[1][1][3][0]), "+v"(acc[1][1][3][1]));
        }
        if constexpr (!Epi::AFTER_DRAIN) { E(acc, cur, wr, wc, fr, fq); S.done(cur); }
        if (!has_next) break;
#pragma unroll
        for (int a = 0; a < 2; ++a)
#pragma unroll
            for (int b = 0; b < 2; ++b)
#pragma unroll
                for (int m = 0; m < 4; ++m)
#pragma unroll
                    for (int n = 0; n < 2; ++n) acc[a][b][m][n] = (f32x4){0.f, 0.f, 0.f, 0.f};
        cur = nxt; cA = nA; cB = nB; ++ui;
        if constexpr (ALIGN_EPI) { if (wr == 1) PG8_BAR; }
    }
    PG8_WAIT_V(0);
    if constexpr (!ALIGN_EPI) { if (wr == 0) PG8_BAR; }
    PG8_BAR;
    if constexpr (Epi::AFTER_DRAIN) { E.fused(acc, cur, wr, wc, fr, fq, lds, wid, lane); S.done(cur); }
#undef PG8_SA
#undef PG8_SB
#undef PG8_STAGE
#undef PG8_LDA
#undef PG8_LDB
#undef PG8_MMA
#undef PG8_WAIT_V
#undef PG8_WAIT_L
#undef PG8_BAR
#undef PG8_SCHED
}
}

namespace att {
typedef unsigned short bf16;
typedef short bf16x8 __attribute__((ext_vector_type(8)));
typedef short s16x4 __attribute__((ext_vector_type(4)));
typedef float f32x16 __attribute__((ext_vector_type(16)));
typedef float f32x4 __attribute__((ext_vector_type(4)));
typedef unsigned u32x4 __attribute__((ext_vector_type(4)));
typedef unsigned u32x2 __attribute__((ext_vector_type(2)));
constexpr int D = 128, NW = 8, QBLK = 32, KVBLK = 64, QB = NW * QBLK;
constexpr int PQ = 6144, PO = 2048;
constexpr int SHM_V = KVBLK * D * 2, SHM_K = KVBLK * D * 2;
constexpr int L_V = 0, L_K = 2 * SHM_V, L_WS = L_K + 2 * SHM_K, L_BIAS = L_WS + NW * 64 * 4, L_KM = L_BIAS + 512, L_Q = L_KM + 8192, L_FB = L_Q + NW * 8192, L_END = L_FB + 4096 * 4;
constexpr float SCALE = 0.08838834764831845f, THR = 8.f;
#define KSWZ(row, colB) ((row) * 256 + ((colB) ^ (((row) & 7) << 4)))
#define SBAR() __builtin_amdgcn_sched_barrier(0)
#ifndef ATT_QREG_FOX
#define ATT_QREG_FOX 1
#endif
#ifndef ATT_QREG_MOBA
#define ATT_QREG_MOBA 1
#endif
#define QREG(MODE) (((MODE) == 1 && ATT_QREG_FOX) || ((MODE) == 0 && ATT_QREG_MOBA))
#define AL __attribute__((address_space(3)))
__device__ __forceinline__ int v_st(int k, int c) { const int kk = (k & ~0xC) | ((k & 4) << 1) | ((k & 8) >> 1); return ((kk >> 3) * 4 + (c >> 5)) * 512 + ((kk & 7) * 32 + (c & 31)) * 2; }
__device__ __forceinline__ int v_rd_base(int lane) { return ((lane & 3) << 3) | (((lane >> 2) & 3) << 6) | (((lane >> 4) & 1) << 5) | (((lane >> 5) & 1) << 8); }
constexpr int v_rd_off(int d0, int ks, int half) { return d0 * 512 + ks * 4096 + half * 2048; }
__device__ __forceinline__ int crow(int r, int hi) { return (r & 3) + 8 * (r >> 2) + 4 * hi; }
__device__ __forceinline__ unsigned cvtpk(float lo, float hi) { unsigned r; asm volatile("v_cvt_pk_bf16_f32 %0, %1, %2" : "=v"(r) : "v"(lo), "v"(hi)); return r; }
__device__ __forceinline__ bf16x8 ld8(__amdgpu_buffer_rsrc_t rs, unsigned voff, unsigned soff) { const u32x4 w = __builtin_amdgcn_raw_buffer_load_b128(rs, (int)voff, (int)soff, 0); return __builtin_bit_cast(bf16x8, w); }
__device__ __forceinline__ void glds16(const void* gsrc, unsigned lds_dst) { unsigned keep;
    asm volatile("s_mov_b32 %0, m0\n\ts_mov_b32 m0, %2\n\ts_nop 0\n\tglobal_load_lds_dwordx4 %1, off\n\ts_mov_b32 m0, %0" : "=&s"(keep) : "v"(gsrc), "s"(lds_dst) : "memory"); }
__device__ __forceinline__ void mask_tile(f32x16& p0, f32x16& p1, int dq) {
    const float NEG = -__builtin_inff();
#pragma unroll
    for (int r = 0; r < 16; ++r) { const int c = (r & 3) + 8 * (r >> 2); if (dq - c < 0) p0[r] = NEG; if (dq - c - 32 < 0) p1[r] = NEG; }
}
__device__ __forceinline__ void partialSM(f32x16& p0, f32x16& p1, float& m_reg, float& mn, float& alpha) {
    float pmax = p0[0]; for (int r = 1; r < 16; ++r) pmax = fmaxf(pmax, p0[r]); for (int r = 0; r < 16; ++r) pmax = fmaxf(pmax, p1[r]);
    { auto rr = __builtin_amdgcn_permlane32_swap(__float_as_uint(pmax), __float_as_uint(pmax), false, false); pmax = fmaxf(__uint_as_float(rr[0]), __uint_as_float(rr[1])); }
    constexpr float C2 = 1.4426950408889634f * SCALE;
    if (__builtin_expect(__all((pmax - m_reg) * SCALE <= THR), 1)) { mn = m_reg; alpha = 1.f; }
    else { mn = fmaxf(m_reg, pmax); alpha = __builtin_amdgcn_exp2f((m_reg - mn) * C2); m_reg = mn; }
    const float mnL = -mn * C2;
    for (int r = 0; r < 16; ++r) p0[r] = fmaf(p0[r], C2, mnL); for (int r = 0; r < 16; ++r) p1[r] = fmaf(p1[r], C2, mnL);
    for (int r = 0; r < 16; ++r) p0[r] = __builtin_amdgcn_exp2f(p0[r]);
}
__device__ __forceinline__ void finishSM(f32x16& p0, f32x16& p1, float alpha, float& l_reg, bf16x8& pa0, bf16x8& pa1, bf16x8& pa2, bf16x8& pa3) {
    for (int r = 0; r < 16; ++r) p1[r] = __builtin_amdgcn_exp2f(p1[r]);
    float ps = 0; for (int r = 0; r < 16; ++r) ps += p0[r]; for (int r = 0; r < 16; ++r) ps += p1[r];
    { auto rr = __builtin_amdgcn_permlane32_swap(__float_as_uint(ps), __float_as_uint(ps), false, false); ps = __uint_as_float(rr[0]) + __uint_as_float(rr[1]); }
    l_reg = l_reg * alpha + ps;
#define PK4(P, B_, OUT) do { unsigned a0 = cvtpk(P[B_+0], P[B_+1]), a1 = cvtpk(P[B_+2], P[B_+3]);                          \
        unsigned b0 = cvtpk(P[B_+4], P[B_+5]), b1 = cvtpk(P[B_+6], P[B_+7]);                                             \
        auto r0 = __builtin_amdgcn_permlane32_swap(a0, b0, false, false); auto r1 = __builtin_amdgcn_permlane32_swap(a1, b1, false, false); \
        u32x4 w = {r0[0], r1[0], r0[1], r1[1]}; OUT = *reinterpret_cast<bf16x8*>(&w); } while (0)
    PK4(p0, 0, pa0); PK4(p0, 8, pa1); PK4(p1, 0, pa2); PK4(p1, 8, pa3);
#undef PK4
}
template <int KB, int MODE>
__device__ __forceinline__ void qkt(f32x16& p0, f32x16& p1, const AL char* lds, int r32, int hi, const AL char* qf, const bf16x8* qr, float rb, int k0) {
    if constexpr (MODE == 1) {
        const AL f32x4* f = (const AL f32x4*)(lds + L_FB + (k0 + 4 * hi) * 4);
        const f32x4 a0 = f[0], a1 = f[2], a2 = f[4], a3 = f[6], b0 = f[8], b1 = f[10], b2 = f[12], b3 = f[14];
        typedef float f32x8 __attribute__((ext_vector_type(8)));
        const f32x8 a01 = __builtin_shufflevector(a0, a1, 0, 1, 2, 3, 4, 5, 6, 7), a23 = __builtin_shufflevector(a2, a3, 0, 1, 2, 3, 4, 5, 6, 7);
        const f32x8 b01 = __builtin_shufflevector(b0, b1, 0, 1, 2, 3, 4, 5, 6, 7), b23 = __builtin_shufflevector(b2, b3, 0, 1, 2, 3, 4, 5, 6, 7);
        p0 = __builtin_shufflevector(a01, a23, 0, 1, 2, 3, 4, 5, 6, 7, 8, 9, 10, 11, 12, 13, 14, 15);
        p1 = __builtin_shufflevector(b01, b23, 0, 1, 2, 3, 4, 5, 6, 7, 8, 9, 10, 11, 12, 13, 14, 15); }
    else {
#pragma unroll
        for (int r = 0; r < 16; ++r) { p0[r] = rb; p1[r] = rb; } }
    const AL char* K_lds = lds + L_K; const AL char* kb[4];
#pragma unroll
    for (int dd = 0; dd < 4; ++dd) kb[dd] = K_lds + KB * SHM_K + KSWZ(r32, (dd * 16 + hi * 8) * 2);
#pragma unroll
    for (int d0 = 0; d0 < 8; ++d0) { const AL char* a = kb[d0 & 3] + (d0 >> 2) * 128;
        bf16x8 b0 = *(const AL bf16x8*)(a);
        bf16x8 b1 = *(const AL bf16x8*)(a + 32 * 256);
        const bf16x8 q = QREG(MODE) ? qr[d0] : *(const AL bf16x8*)(qf + d0 * 1024);
        p0 = __builtin_amdgcn_mfma_f32_32x32x16_bf16(b0, q, p0, 0, 0, 0);
        p1 = __builtin_amdgcn_mfma_f32_32x32x16_bf16(b1, q, p1, 0, 0, 0); }
}
template <int VB>
__device__ __forceinline__ void pv_tile(f32x16* o, int vb0, bf16x8 pa0, bf16x8 pa1, bf16x8 pa2, bf16x8 pa3) {
#define TRRD(dst, off) asm volatile("ds_read_b64_tr_b16 %0, %1 offset:%2" : "=&v"(dst) : "v"(vb0), "i"(off) : "memory")
#define PV_D0(d0) do { s16x4 l0, l1, l2, l3, h0, h1, h2, h3; constexpr int b_ = VB * SHM_V + v_rd_off(d0, 0, 0);   \
        TRRD(l0, b_); TRRD(h0, b_ + 2048); TRRD(l1, b_ + 4096); TRRD(h1, b_ + 6144); TRRD(l2, b_ + 8192); TRRD(h2, b_ + 10240); TRRD(l3, b_ + 12288); TRRD(h3, b_ + 14336); \
        asm volatile("s_waitcnt lgkmcnt(0)" ::: "memory"); SBAR();                                                    \
        o[d0] = __builtin_amdgcn_mfma_f32_32x32x16_bf16(pa0, (bf16x8){l0[0], l0[1], l0[2], l0[3], h0[0], h0[1], h0[2], h0[3]}, o[d0], 0, 0, 0);   \
        o[d0] = __builtin_amdgcn_mfma_f32_32x32x16_bf16(pa1, (bf16x8){l1[0], l1[1], l1[2], l1[3], h1[0], h1[1], h1[2], h1[3]}, o[d0], 0, 0, 0);   \
        o[d0] = __builtin_amdgcn_mfma_f32_32x32x16_bf16(pa2, (bf16x8){l2[0], l2[1], l2[2], l2[3], h2[0], h2[1], h2[2], h2[3]}, o[d0], 0, 0, 0);   \
        o[d0] = __builtin_amdgcn_mfma_f32_32x32x16_bf16(pa3, (bf16x8){l3[0], l3[1], l3[2], l3[3], h3[0], h3[1], h3[2], h3[3]}, o[d0], 0, 0, 0); } while (0)
    PV_D0(0); PV_D0(1); PV_D0(2); PV_D0(3);
#undef PV_D0
#undef TRRD
}
struct Ref { unsigned Q, K, V, O; int qb; int row0, head16; };
struct Seam { bf16x8 st_v0, st_v1, st_k0, st_k1; };
#define VMW() asm volatile("s_waitcnt vmcnt(0)" ::: "memory")
#define VMWN(n) asm volatile("s_waitcnt vmcnt(%0)" :: "i"(n) : "memory")
#define SLOAD_H(R, k0) do { const unsigned kt_ = (R).K + (unsigned)(k0) * (2u * PQ), vt_ = (R).V + (unsigned)(k0) * (2u * PQ);                                                                \
                            S.st_v0 = ld8(rsq, vo0, vt_); S.st_v1 = ld8(rsq, vo1, vt_); S.st_k0 = ld8(rsq, vo0, kt_); S.st_k1 = ld8(rsq, vo1, kt_); } while (0)
#define SWRITE_HK(bf) do { *(AL bf16x8*)(K_lds + (bf) * SHM_K + kws) = S.st_k0; *(AL bf16x8*)(K_lds + (bf) * SHM_K + kws + 32 * 256) = S.st_k1; } while (0)
#define SWRITE_HV(bf) do { *(AL bf16x8*)(V_lds + (bf) * SHM_V + vst0) = S.st_v0; *(AL bf16x8*)(V_lds + (bf) * SHM_V + vst1) = S.st_v1; } while (0)
#define SWRITE_H(bf) do { SWRITE_HV(bf); SWRITE_HK(bf); } while (0)
#define ATT_IDS int tid_ = threadIdx.x; asm volatile("" : "+v"(tid_)); const int tid = tid_, wid = __builtin_amdgcn_readfirstlane(tid >> 6), lane = tid & 63, r32 = lane & 31, hi = lane >> 5;   \
    const int sr = tid >> 4, sc = (tid & 15) * 8, kws = KSWZ(sr, sc * 2);                                                                           \
    const unsigned vo0 = 2u * (unsigned)(sr * PQ + sc), vo1 = vo0 + 64u * PQ, voq = 2u * (unsigned)((wid * QBLK + r32) * PQ + hi * 8); (void)vo0; (void)vo1; (void)voq;     \
    AL char* V_lds = lds + L_V; AL char* K_lds = lds + L_K; (void)V_lds; (void)hi; (void)r32;                                                \
    const AL char* qf = lds + L_Q + wid * 8192 + lane * 16; const unsigned qdma = (unsigned)(uintptr_t)(lds + L_Q) + (unsigned)wid * 8192u; (void)qf; (void)qdma
template <int MODE>
__device__ __forceinline__ void prime(const Ref& cur, AL char* lds, Seam& S, __amdgpu_buffer_rsrc_t rsq, const char* qkvb) {
    ATT_IDS;
#pragma unroll
    for (int d0 = 0; d0 < 8; ++d0) glds16(qkvb + cur.Q + voq + d0 * 32, (unsigned)__builtin_amdgcn_readfirstlane(qdma + d0 * 1024));
    SLOAD_H(cur, 0); VMW(); SWRITE_HK(0);
    __syncthreads();
}
template <int MODE>
__device__ __forceinline__ void block(const Ref& cur, const Ref& nxt, AL char* lds, Seam& S, unsigned selmask, __amdgpu_buffer_rsrc_t rsq, __amdgpu_buffer_rsrc_t rso, const char* qkvb, float* ssq) {
    ATT_IDS;
    const int NT = 4 * (cur.qb + 1);
    const int qlo = cur.qb * QB + wid * QBLK, qm = qlo + r32 - 4 * hi;
    AL float* ws = (AL float*)(lds + L_WS) + wid * 64; AL float* li_l = ws; AL float* al_l = ws + 32;
    float m_reg = -1e30f, l_reg = 0; f32x16 o[4] = {};
    const int vst0 = v_st(sr, sc), vst1 = v_st(32 + sr, sc);
    const int vb0 = (int)(unsigned)(uintptr_t)V_lds + v_rd_base(lane);
    const float NEGI = -__builtin_inff();
#define RESC(a) do { if (__any((a) < 1.f)) { if (hi == 0) al_l[r32] = (a); asm volatile("s_waitcnt lgkmcnt(0)" ::: "memory");              \
                     for (int d_ = 0; d_ < 4; ++d_) for (int r = 0; r < 16; ++r) o[d_][r] *= al_l[crow(r, hi)]; } } while (0)
#define KBASE(t) ((t) * KVBLK)
#define RB(t) ((MODE == 0) ? (((selmask >> ((t) >> 2)) & 1u) ? 0.f : NEGI) : 0.f)
#define MASKT(P0_, P1_, t) do { const int kb_ = KBASE(t); if (kb_ + KVBLK - 1 > qlo) mask_tile(P0_, P1_, qm - kb_); } while (0)
#define SEAM_K0() do { VMWN(8); SWRITE_HK(0); SBAR(); } while (0)
    f32x16 pA0, pA1, pB0, pB1; float mnA, mnB, alA, alB; bf16x8 pa0, pa1, pa2, pa3;
    bf16x8 qr[8];
    if constexpr (QREG(MODE)) {
#pragma unroll
        for (int d0 = 0; d0 < 8; ++d0) qr[d0] = *(const AL bf16x8*)(qf + d0 * 1024); }
    SWRITE_HV(0); SBAR();
    SLOAD_H(cur, KBASE(1));
    SBAR(); qkt<0, MODE>(pA0, pA1, lds, r32, hi, qf, qr, RB(0), 0);
    MASKT(pA0, pA1, 0); partialSM(pA0, pA1, m_reg, mnA, alA);
    VMW(); SWRITE_H(1);
    __syncthreads();
#define HALF_STEP(PX0, PX1, mnX, alX, PY0, PY1, alY, t, KB, VB, SB) do {                                                      \
        SBAR(); qkt<KB, MODE>(PX0, PX1, lds, r32, hi, qf, qr, RB(t), KBASE(t));                                                          \
        finishSM(PY0, PY1, alY, l_reg, pa0, pa1, pa2, pa3); SBAR();                                                           \
        if ((t) + 1 < NT) { SLOAD_H(cur, KBASE((t) + 1)); SBAR(); }                                                           \
        pv_tile<VB>(o, vb0, pa0, pa1, pa2, pa3); MASKT(PX0, PX1, (t)); partialSM(PX0, PX1, m_reg, mnX, alX);                  \
        __syncthreads();                                                                                                      \
        if ((t) + 1 < NT) { VMW(); SWRITE_H(SB); }                                                                            \
        RESC(alX); __syncthreads(); } while (0)
    for (int t = 1; t + 1 < NT; t += 2) {
        HALF_STEP(pB0, pB1, mnB, alB, pA0, pA1, alA, t, 1, 0, 0);
        HALF_STEP(pA0, pA1, mnA, alA, pB0, pB1, alB, t + 1, 0, 1, 1);
    }
    SBAR(); qkt<1, MODE>(pB0, pB1, lds, r32, hi, qf, qr, RB(NT - 1), KBASE(NT - 1)); asm volatile("s_waitcnt lgkmcnt(0)" ::: "memory"); SBAR();
    SLOAD_H(nxt, 0); SBAR();
#pragma unroll
    for (int d0 = 0; d0 < 8; ++d0) glds16(qkvb + nxt.Q + voq + d0 * 32, (unsigned)__builtin_amdgcn_readfirstlane(qdma + d0 * 1024));
    SBAR();
    finishSM(pA0, pA1, alA, l_reg, pa0, pa1, pa2, pa3); SBAR();
    pv_tile<0>(o, vb0, pa0, pa1, pa2, pa3);
    MASKT(pB0, pB1, NT - 1); partialSM(pB0, pB1, m_reg, mnB, alB); __syncthreads(); RESC(alB);
    finishSM(pB0, pB1, alB, l_reg, pa0, pa1, pa2, pa3); SBAR(); pv_tile<1>(o, vb0, pa0, pa1, pa2, pa3);
    SBAR(); SEAM_K0();
    if (hi == 0) li_l[r32] = l_reg; asm volatile("s_waitcnt lgkmcnt(0)" ::: "memory");
    float rli[16];
#pragma unroll
    for (int r = 0; r < 16; ++r) rli[r] = __builtin_amdgcn_rcpf(li_l[crow(r, hi)]);
    const unsigned vofo = 2u * (unsigned)(hi * 4 * PO + r32);
    float sq[16];
#pragma unroll
    for (int r = 0; r < 16; ++r) { const unsigned Or = cur.O + (unsigned)(wid * QBLK + (r & 3) + 8 * (r >> 2)) * (2u * PO);
        float s2 = 0.f;
#pragma unroll
        for (int d0 = 0; d0 < 4; ++d0) { const float v = o[d0][r] * rli[r]; s2 += v * v;
            const float vn = __shfl_xor(v, 1);
            if ((r32 & 1) == 0) __builtin_amdgcn_raw_buffer_store_b32(cvtpk(v, vn), rso, (int)(vofo + d0 * 64), (int)Or, 0); }
        sq[r] = s2; }
    {
        float a8[8], a4[4], a2[2], a1;
        const bool b4 = (r32 & 16) != 0, b3 = (r32 & 8) != 0, b2 = (r32 & 4) != 0, b1 = (r32 & 2) != 0;
#pragma unroll
        for (int i = 0; i < 8; ++i) { const float send = b4 ? sq[i] : sq[i + 8], keep = b4 ? sq[i + 8] : sq[i]; a8[i] = keep + __shfl_xor(send, 16); }
#pragma unroll
        for (int i = 0; i < 4; ++i) { const float send = b3 ? a8[i] : a8[i + 4], keep = b3 ? a8[i + 4] : a8[i]; a4[i] = keep + __shfl_xor(send, 8); }
#pragma unroll
        for (int i = 0; i < 2; ++i) { const float send = b2 ? a4[i] : a4[i + 2], keep = b2 ? a4[i + 2] : a4[i]; a2[i] = keep + __shfl_xor(send, 4); }
        { const float send = b1 ? a2[0] : a2[1], keep = b1 ? a2[1] : a2[0]; a1 = keep + __shfl_xor(send, 2); }
        a1 += __shfl_xor(a1, 1);
        const int r = r32 >> 1, rowl = wid * QBLK + (r & 3) + 8 * (r >> 2) + 4 * hi;
        if ((r32 & 1) == 0) ssq[((size_t)cur.row0 + rowl) * 16 + cur.head16] = a1;
    }
    __syncthreads();
#undef RESC
#undef KBASE
#undef RB
#undef MASKT
#undef SEAM_K0
#undef HALF_STEP
}
__device__ __forceinline__ unsigned moba_select(const AL char* qf, const AL char* lds, int qb, int r32, int hi) {
    f32x16 g = {};
    const AL char* kb[4];
#pragma unroll
    for (int dd = 0; dd < 4; ++dd) kb[dd] = lds + L_KM + KSWZ(r32, (dd * 16 + hi * 8) * 2);
#pragma unroll
    for (int d0 = 0; d0 < 8; ++d0) { const bf16x8 b0 = *(const AL bf16x8*)(kb[d0 & 3] + (d0 >> 2) * 128); g = __builtin_amdgcn_mfma_f32_32x32x16_bf16(b0, *(const AL bf16x8*)(qf + d0 * 1024), g, 0, 0, 0); }
    float gv[16];
#pragma unroll
    for (int i = 0; i < 8; ++i) { auto rr = __builtin_amdgcn_permlane32_swap(__float_as_uint(g[i]), __float_as_uint(g[i]), false, false);
        const int bl = (i & 3) + 8 * (i >> 2); gv[bl] = __uint_as_float(rr[0]); gv[bl + 4] = __uint_as_float(rr[1]); }
    unsigned mask = 0u;
#pragma unroll
    for (int p = 0; p < 3; ++p) { float best = -__builtin_inff(); int bi = -1;
#pragma unroll
        for (int n = 0; n < 16; ++n) { const bool c = (n < qb) && (((mask >> n) & 1u) == 0u) && (gv[n] > best); best = c ? gv[n] : best; bi = c ? n : bi; }
        if (bi >= 0) mask |= 1u << bi; }
    return mask | (1u << qb);
}
struct Tensors { const bf16* QKV; bf16* OB; const float* LOGF; const float* KSUM; float* SSQ; };
template <int MODE>
__device__ __forceinline__ Ref mkref(const Tensors& T, int bh, int qb) {
    const int b = bh >> 3, h = bh & 7; Ref r;
    const unsigned row0 = (unsigned)b * 4096u;
    constexpr unsigned QC = MODE == 0 ? 0 : 3072, KC = MODE == 0 ? 1024 : 4096, VC = MODE == 0 ? 2048 : 5120, OC = MODE == 0 ? 0 : 1024;
    r.Q = 2u * ((row0 + (unsigned)qb * QB) * PQ + QC + h * D); r.K = 2u * (row0 * PQ + KC + h * D); r.V = 2u * (row0 * PQ + VC + h * D);
    r.O = 2u * ((row0 + (unsigned)qb * QB) * PO + OC + h * D); r.qb = qb; r.row0 = (int)(row0 + (unsigned)qb * QB); r.head16 = (MODE == 0 ? 0 : 8) + h; return r;
}
template <int MODE>
__device__ __forceinline__ void attn_phase(AL char* lds, const Tensors& T, int vcu, int G) {
    int tid_ = threadIdx.x; asm volatile("" : "+v"(tid_));
    const int tid = tid_, lane = tid & 63, r32 = lane & 31, hi = lane >> 5, wid = __builtin_amdgcn_readfirstlane(tid >> 6);
    const AL char* qf = lds + L_Q + wid * 8192 + lane * 16;
    const __amdgpu_buffer_rsrc_t rsq = __builtin_amdgcn_make_buffer_rsrc((void*)T.QKV, (short)0, (int)(16384u * PQ * 2u), 0x00020000);
    const __amdgpu_buffer_rsrc_t rso = __builtin_amdgcn_make_buffer_rsrc((void*)T.OB, (short)0, (int)(16384u * PO * 2u), 0x00020000);
    const char* qkvb = (const char*)T.QKV;
    for (int item = vcu; item < 256; item += G) {
        const int bh = item >> 3, s = item & 7;
        if constexpr (MODE == 0) {
            const int row = tid >> 5, c4 = (tid & 31) * 4;
            const f32x4 v = *(const f32x4*)((const char*)(T.KSUM + (size_t)bh * 2048) + 4u * (unsigned)(row * 128 + c4)) * (1.0f / 256.0f);
            u32x2 w; w.x = cvtpk(v[0], v[1]); w.y = cvtpk(v[2], v[3]);
            *(AL u32x2*)(lds + L_KM + KSWZ(row, c4 * 2)) = w;
        }
        if constexpr (MODE == 1) {
            AL float* fbL = (AL float*)(lds + L_FB); AL float* wsum = (AL float*)(lds + L_BIAS);
            const float* lf = T.LOGF + (size_t)bh * 4096 + wid * 512 + lane * 8;
            f32x4 a = *(const f32x4*)lf, b = *(const f32x4*)(lf + 4);
            a[1] += a[0]; a[2] += a[1]; a[3] += a[2]; b[0] += a[3]; b[1] += b[0]; b[2] += b[1]; b[3] += b[2];
            float inc = b[3];
#pragma unroll
            for (int o = 1; o < 64; o <<= 1) { const float t = __shfl_up(inc, o); if (lane >= o) inc += t; }
            if (lane == 63) wsum[wid] = inc;
            __syncthreads();
            float base = inc - b[3];
#pragma unroll
            for (int w = 0; w < 7; ++w) if (w < wid) base += wsum[w];
            constexpr float NIS = -11.313708498984761f;
            *(AL f32x4*)(fbL + wid * 512 + lane * 8) = (a + base) * NIS; *(AL f32x4*)(fbL + wid * 512 + lane * 8 + 4) = (b + base) * NIS;
        }
        Ref cur = mkref<MODE>(T, bh, s), nxt = mkref<MODE>(T, bh, 15 - s);
        Seam S; prime<MODE>(cur, lds, S, rsq, qkvb);
        for (int i = 0; i < 2; ++i) {
            unsigned selmask = 0u;
            VMW();
            if constexpr (MODE == 0) selmask = moba_select(qf, lds, cur.qb, r32, hi);
            block<MODE>(cur, nxt, lds, S, selmask, rsq, rso, qkvb, T.SSQ);
            cur = nxt;
        }
    }
}
#undef VMW
#undef VMWN
#undef SLOAD_H
#undef SWRITE_HK
#undef SWRITE_HV
#undef SWRITE_H
#undef ATT_IDS
#undef KSWZ
#undef SBAR
#undef AL
}

constexpr int NWAVES = 8;
constexpr int DM = 2048, NB = 4, SEQ = 4096, NTOK = NB * SEQ, NLAYER = 2, NHG = 8, HD = 128;
constexpr int INW = 6152, NQKV = 6144, DFF = 7168, NEXP = 8, NGU = 2 * DFF;
constexpr int MOE_ROWS = 34816;
constexpr float EPS = 1e-6f;
constexpr size_t MiB = 1u << 20;
constexpr size_t WS_CTL = 0, CTL_ZERO_BYTES = 1 * MiB;
constexpr size_t WS_MOD = 1 * MiB;
constexpr size_t WS_ROPE = 2 * MiB;
constexpr size_t WS_WFZ = 4 * MiB;
constexpr size_t WS_LOGF = 5 * MiB;
constexpr size_t WS_FBIAS = 6 * MiB;
constexpr size_t WS_KMEAN = 7 * MiB;
constexpr size_t WS_ROUTE = 8 * MiB;
constexpr size_t WS_PART = 9 * MiB;
constexpr size_t WS_WIN = 21 * MiB;
constexpr size_t WS_WO = 69 * MiB;
constexpr size_t WS_WGU = 85 * MiB;
constexpr size_t WS_WD = 589 * MiB;
constexpr size_t WS_WGU8 = WS_WGU + 56 * MiB, WS_WD8 = WS_WD + 28 * MiB;
constexpr size_t WS_XB = WS_WGU + 288 * MiB;
constexpr size_t WS_H = 841 * MiB;
constexpr size_t WS_A = 905 * MiB;
constexpr size_t WS_QKV = WS_A, WS_O = WS_A + 192 * MiB, WS_ACT = WS_A + 256 * MiB;
constexpr size_t WS_HS = WS_A, WS_ACTM = WS_A + 136 * MiB, WS_YS = WS_A + 612 * MiB;
constexpr size_t WS_YP = WS_YS + 136 * MiB;
constexpr size_t WS_END = WS_A + 884 * MiB;
static_assert((size_t)MOE_ROWS * DM * 2 <= 136 * MiB && (size_t)MOE_ROWS * DFF * 2 <= 476 * MiB && (size_t)MOE_ROWS * DM * 4 <= 272 * MiB, "MoE overlay");
static_assert((size_t)NTOK * NQKV * 2 <= 192 * MiB && (size_t)NTOK * DFF * 2 <= 224 * MiB, "layer overlay");
constexpr int CW_BAR = 4096;
constexpr size_t WS_TAB = 512 * 1024;
constexpr int RING_OFF = 0, RING_BYTES = 159744;
constexpr int LDSCTL_OFF = RING_BYTES, MISC_OFF = LDSCTL_OFF + 320;
constexpr int TILE_E_OFF = LDSCTL_OFF + 1024;
constexpr int RS_OFF = 131072, RS_UNITS = 4;
constexpr int LDS_BYTES = 163840;
static_assert(att::L_END <= RING_BYTES && TILE_E_OFF + 1024 <= LDS_BYTES && pg8::STAGE_BYTES <= RING_BYTES, "LDS map");

#define GAS __attribute__((address_space(1)))
#define LAS __attribute__((address_space(3)))
typedef unsigned short bf16;
typedef unsigned v4u __attribute__((ext_vector_type(4)));
typedef unsigned v2u __attribute__((ext_vector_type(2)));
typedef float f32x4 __attribute__((ext_vector_type(4)));
typedef GAS unsigned gu32;
#define RLX_AGENT __ATOMIC_RELAXED, __HIP_MEMORY_SCOPE_AGENT
#define LDS_WAIT() asm volatile("s_waitcnt lgkmcnt(0)" ::: "memory")
__device__ __forceinline__ unsigned f2bf(float f) { unsigned u = __builtin_bit_cast(unsigned, f); return (u + 0x7fffu + ((u >> 16) & 1u)) >> 16; }
__device__ __forceinline__ unsigned pk2(float lo, float hi) { return f2bf(lo) | (f2bf(hi) << 16); }
__device__ __forceinline__ float bf2f(unsigned short b) { return __builtin_bit_cast(float, (unsigned)b << 16); }
__device__ __forceinline__ float wave_sum(float v) {
#pragma unroll
    for (int o = 1; o < 64; o <<= 1) v += __shfl_xor(v, o);
    return v;
}
#define XB_TMO      128
#define XB_XCNT(j)  (256  + 64 * (j))
#define XB_XSUB(j)  (1280 + 64 * (j))
#define XB_XGEN(j)  (2304 + 64 * (j))
#define XB_TOP      3328
#define XB_TOPGEN   3392
#define XCD_BAR_WORDS 3456
#define XB_SPIN_CAP (1u << 18)

__device__ __forceinline__ unsigned xb_ld(unsigned* p)              { return __hip_atomic_load((GAS unsigned*)p, __ATOMIC_RELAXED, __HIP_MEMORY_SCOPE_AGENT); }
__device__ __forceinline__ unsigned xb_add(unsigned* p, unsigned v) { return __hip_atomic_fetch_add((GAS unsigned*)p, v, __ATOMIC_RELAXED, __HIP_MEMORY_SCOPE_AGENT); }
__device__ __forceinline__ unsigned xb_xcc_id() { return (unsigned)__builtin_amdgcn_s_getreg((3 << 11) | 20) & 0xFu; }
#define XB_SPIN(cond, bar) do { unsigned _sp = 0; while (cond) { __builtin_amdgcn_s_sleep(1); \
    if ((++_sp & 255u) == 0u) { if (xb_ld(&(bar)[XB_TMO])) break; if (_sp > XB_SPIN_CAP) { (void)xb_add(&(bar)[XB_TMO], 1u); break; } } } } while (0)

struct XcdBarrier {
    unsigned* bar; unsigned x;
    volatile LAS unsigned* st;
};

__device__ __forceinline__ XcdBarrier xcd_barrier_post(unsigned* bar, volatile LAS unsigned* st) {
    XcdBarrier b; b.bar = bar; b.x = xb_xcc_id(); b.st = st;
    if (threadIdx.x == 0) (void)xb_add(&bar[XB_XCNT(b.x)], 1u);
    return b;
}
__device__ __forceinline__ void xcd_barrier_complete(unsigned* bar, unsigned x, unsigned& nloc, unsigned& nx) {
    const unsigned G = gridDim.x * gridDim.y * gridDim.z;
    unsigned sum, cnt, mine, sp = 0u;
    for (;;) {
        sum = 0u; cnt = 0u; mine = 0u;
#pragma unroll
        for (unsigned j = 0; j < 16; ++j) { const unsigned c = xb_ld(&bar[XB_XCNT(j)]); sum += c; cnt += (c > 0u) ? 1u : 0u; mine = (j == x) ? c : mine; }
        if (sum == G) break;
        __builtin_amdgcn_s_sleep(1);
        if ((++sp & 255u) == 0u) { if (xb_ld(&bar[XB_TMO])) break; if (sp > XB_SPIN_CAP) { (void)xb_add(&bar[XB_TMO], 1u); break; } }
    }
    nloc = mine > 0u ? mine : 1u; nx = cnt > 0u ? cnt : 1u;
}

__device__ __attribute__((noinline)) void xcd_barrier(const XcdBarrier b) {
    asm volatile("s_waitcnt vmcnt(0)" ::: "memory");
    __syncthreads();
    if (threadIdx.x == 0) {
        unsigned* bar = b.bar;
        __builtin_amdgcn_s_waitcnt(0);
        unsigned nloc = b.st[0], nx = b.st[1];
        if (nloc == 0u) { xcd_barrier_complete(bar, b.x, nloc, nx); b.st[0] = nloc; b.st[1] = nx; }
        const unsigned old = xb_add(&bar[XB_XSUB(b.x)], 1u);
        const unsigned gen = old / nloc;
        if (old + 1u == (gen + 1u) * nloc) {
            __builtin_amdgcn_fence(__ATOMIC_RELEASE, "agent");
            asm volatile("s_waitcnt vmcnt(0)" ::: "memory");
            const unsigned og = xb_add(&bar[XB_TOP], 1u);
            const unsigned tg = og / nx;
            if (og + 1u == (tg + 1u) * nx) xb_add(&bar[XB_TOPGEN], 1u);
            else XB_SPIN(xb_ld(&bar[XB_TOPGEN]) == tg, bar);
            __builtin_amdgcn_fence(__ATOMIC_ACQUIRE, "agent");
            xb_add(&bar[XB_XGEN(b.x)], 1u);
            asm volatile("s_waitcnt vmcnt(0)" ::: "memory");
        } else {
            XB_SPIN(xb_ld(&bar[XB_XGEN(b.x)]) == gen, bar);
            __builtin_amdgcn_fence(__ATOMIC_ACQUIRE, "agent");
            asm volatile("s_waitcnt vmcnt(0)" ::: "memory");
        }
    }
    __syncthreads();
}

#ifndef DENSE_FP8
#define DENSE_FP8 1
#endif
#ifndef WGM_INPROJ
#define WGM_INPROJ 4
#endif
#ifndef WGM_WO
#define WGM_WO 4
#endif
#ifndef WGM_DUP
#define WGM_DUP 4
#endif
#ifndef WGM_DDOWN
#define WGM_DDOWN 4
#endif
#ifndef WGM_MUP
#define WGM_MUP 4
#endif
#ifndef WGM_MDOWN
#define WGM_MDOWN 4
#endif
#ifndef CONV_SPLIT
#define CONV_SPLIT 1
#endif
#ifndef CONV_CUS_A
#define CONV_CUS_A 64
#endif
#ifndef CONV_CUS_B
#define CONV_CUS_B 32
#endif
#ifndef CONV_NT
#define CONV_NT 1
#endif
#ifndef CONV_KEEP_PCT
#define CONV_KEEP_PCT 12
#endif
#ifndef CONV_A_PCT
#define CONV_A_PCT 58
#endif
#ifndef MOE_SPLIT
#define MOE_SPLIT 1
#endif
__device__ __forceinline__ int moe_split_s(int nR, int G) { int s = 1; if (nR * 8 * 2 <= G) s = 2; if (nR * 8 * 4 <= G) s = 4; if (nR * 8 * 7 <= G) s = 7; if (nR * 8 * 14 <= G) s = 14; return s; }
enum { I_x, I_c, I_attn_norm_g, I_ada_w, I_ada_b, I_w_in, I_forget_b, I_moba_out_g, I_fox_out_g, I_w_o, I_ffn_norm_g, I_dense_w_gate, I_dense_w_up, I_dense_w_down,
       I_router_w, I_moe_w_gate, I_moe_w_up, I_moe_w_down, I_final_norm_g, N_IN };
struct Args { const float* in[N_IN]; float* out; unsigned char* ws; };
__device__ __forceinline__ const float* inp(const unsigned char* ws, int i) {
    const unsigned long long v = __hip_atomic_load((GAS unsigned long long*)(ws + WS_TAB) + i, __ATOMIC_RELAXED, __HIP_MEMORY_SCOPE_AGENT);
    const unsigned lo = (unsigned)__builtin_amdgcn_readfirstlane((int)(unsigned)v), hi = (unsigned)__builtin_amdgcn_readfirstlane((int)(unsigned)(v >> 32));
    return (const float*)(((unsigned long long)hi << 32) | lo);
}
#define INP(name) inp(a.ws, I_##name)
struct Frame {
    LAS unsigned char* lds; volatile LAS unsigned* MISC; gu32* ctl;
    int tid, lane, wave, vcu, G;
};

template <int MAP> __device__ __forceinline__ int map_row(int c) {
    if (MAP == 1) { if (c >= 2048) return c; const int d = c & 127, dd = d & 63; return (c & ~127) + 8 * (dd >> 2) + 4 * (d >> 6) + (dd & 3); }
    if (MAP == 2) return (c >> 7) * 256 + (c & 127);
    if (MAP == 3) return (c >> 7) * 256 + 128 + (c & 127);
    return c;
}
template <int MAP>
__device__ __forceinline__ void transpose_item(const float* W, int ldw, int K, int nblk, bf16* WT, const float* kscale, LAS float* scr, int item, int lane) {
    const int kb = item / nblk, nb = item - kb * nblk, k0 = 64 * kb, n0 = 32 * nb;
#pragma unroll
    for (int i = 0; i < 8; ++i) { const int kk = 8 * i + (lane >> 3), c4 = (lane & 7) * 4; f32x4 v = *(const GAS f32x4*)(W + (size_t)(k0 + kk) * ldw + n0 + c4); if (kscale) v = v * kscale[k0 + kk];
        LAS float* d = scr + kk * 33 + c4; d[0] = v.x; d[1] = v.y; d[2] = v.z; d[3] = v.w; }
    LDS_WAIT(); asm volatile("" ::: "memory");
    const int c = lane & 7;
#pragma unroll
    for (int j = 0; j < 4; ++j) { const int n = (lane >> 3) + 8 * j; const LAS float* s = scr + (8 * c) * 33 + n;
        v4u o; o.x = pg8::cvt_pk_bf16(s[0 * 33], s[1 * 33]); o.y = pg8::cvt_pk_bf16(s[2 * 33], s[3 * 33]); o.z = pg8::cvt_pk_bf16(s[4 * 33], s[5 * 33]); o.w = pg8::cvt_pk_bf16(s[6 * 33], s[7 * 33]);
        *(GAS v4u*)(WT + (size_t)map_row<MAP>(n0 + n) * K + k0 + 8 * c) = o; }
    LDS_WAIT(); asm volatile("" ::: "memory");
}
template <int MAP>
__device__ __forceinline__ void transpose_item8(const float* W, int ldw, int K, int nblk, unsigned char* WT, float scale, LAS float* scr, int item, int lane) {
    const int kb = item / nblk, nb = item - kb * nblk, k0 = 128 * kb, n0 = 32 * nb;
#pragma unroll
    for (int i = 0; i < 16; ++i) { const int kk = 8 * i + (lane >> 3), c4 = (lane & 7) * 4; const f32x4 v = *(const GAS f32x4*)(W + (size_t)(k0 + kk) * ldw + n0 + c4) * scale;
        LAS float* d = scr + kk * 33 + c4; d[0] = v.x; d[1] = v.y; d[2] = v.z; d[3] = v.w; }
    LDS_WAIT(); asm volatile("" ::: "memory");
    const int c = lane & 7;
#pragma unroll
    for (int j = 0; j < 4; ++j) { const int n = (lane >> 3) + 8 * j; const LAS float* s = scr + (16 * c) * 33 + n;
        v4u o; o.x = pg8::pk_fp8x4(s[0 * 33], s[1 * 33], s[2 * 33], s[3 * 33]); o.y = pg8::pk_fp8x4(s[4 * 33], s[5 * 33], s[6 * 33], s[7 * 33]);
        o.z = pg8::pk_fp8x4(s[8 * 33], s[9 * 33], s[10 * 33], s[11 * 33]); o.w = pg8::pk_fp8x4(s[12 * 33], s[13 * 33], s[14 * 33], s[15 * 33]);
        *(GAS v4u*)(WT + (size_t)map_row<MAP>(n0 + n) * K + k0 + 16 * c) = o; }
    LDS_WAIT(); asm volatile("" ::: "memory");
}
__device__ __forceinline__ void p0a(Frame& F0, const Args& a) {
    Frame F = F0; asm volatile("" : "+v"(F.tid), "+v"(F.lane));
    LAS float* ca = (LAS float*)(F.lds + RING_OFF);
    for (int i = F.tid; i < NB * DM; i += NWAVES * 64) { const float v = a.in[I_c][i]; ca[i] = v / (1.f + expf(-v)); }
    __syncthreads();
    const int gw = F.vcu * NWAVES + F.wave, NGW = F.G * NWAVES;
    float* part = (float*)(a.ws + WS_PART);
    for (int it = gw; it < 2 * 32 * 48; it += NGW) {
        const int cg = it % 48, lc = it / 48, chunk = lc & 31, l = lc >> 5, j0 = cg * 256 + 4 * F.lane;
        const float* w = a.in[I_ada_w] + ((size_t)l * DM + chunk * 64) * 12288 + j0;
        f32x4 s0 = {0.f, 0.f, 0.f, 0.f}, s1 = s0, s2 = s0, s3 = s0;
#pragma unroll 16
        for (int dd = 0; dd < 64; ++dd) { const f32x4 wv = *(const GAS f32x4*)(w + (size_t)dd * 12288); const int d = chunk * 64 + dd;
            s0 += ca[d] * wv; s1 += ca[DM + d] * wv; s2 += ca[2 * DM + d] * wv; s3 += ca[3 * DM + d] * wv; }
        float* pp = part + ((size_t)(chunk * 2 + l) * 4) * 12288 + j0;
        *(f32x4*)(pp) = s0; *(f32x4*)(pp + 12288) = s1; *(f32x4*)(pp + 2 * 12288) = s2; *(f32x4*)(pp + 3 * 12288) = s3;
    }
    const int gt = F.vcu * (NWAVES * 64) + F.tid, NGT = F.G * NWAVES * 64;
    float* ropeT = (float*)(a.ws + WS_ROPE);
    for (int i = gt; i < SEQ * 64; i += NGT) {
        const int pos = i >> 6, dp = i & 63;
        const float invf = (float)exp2(-(double)(2 * dp) / 128.0 * 13.287712379549449);
        const float angf = (float)pos * invf;
        float* t = ropeT + ((size_t)pos * 16 + (dp >> 2)) * 8 + (dp & 3);
        t[0] = (float)cos((double)angf); t[4] = (float)sin((double)angf);
    }
    float* wfz = (float*)(a.ws + WS_WFZ);
    for (int i = gt; i < NLAYER * 8 * DM; i += NGT) { const int d = i & (DM - 1), j = (i >> 11) & 7, l = i >> 14; wfz[i] = a.in[I_w_in][((size_t)l * DM + d) * INW + NQKV + j]; }
    if (F.tid == 0) { GAS unsigned long long* tab = (GAS unsigned long long*)(a.ws + WS_TAB);
#pragma unroll
        for (int i = 0; i < N_IN; ++i) tab[i] = (unsigned long long)a.in[i]; }
}
__device__ __forceinline__ bool conv_split(int G) { return CONV_SPLIT && DENSE_FP8 && G == 256; }
template <int MODE>
__device__ __forceinline__ void p0b(Frame& F0, const Args& a) {
    Frame F = F0; asm volatile("" : "+v"(F.tid), "+v"(F.lane));
    if (MODE == 0) {
    const int gt = F.vcu * (NWAVES * 64) + F.tid, NGT = F.G * NWAVES * 64;
    const float* part = (const float*)(a.ws + WS_PART); float* mod = (float*)(a.ws + WS_MOD); const float* adab = INP(ada_b);
    for (int i = gt; i < NLAYER * NB * 12288; i += NGT) {
        const int j = i % 12288, l = i / (4 * 12288); float s = adab[l * 12288 + j];
#pragma unroll 8
        for (int ch = 0; ch < 32; ++ch) s += part[(size_t)ch * (8 * 12288) + i];
        mod[i] = s;
    }
    }
    LAS float* scr = (LAS float*)(F.lds + RING_OFF + F.wave * 16896);
    constexpr int CCUS = MODE == 1 ? CONV_CUS_A : CONV_CUS_B;
    const int gw = MODE == 0 ? F.vcu * NWAVES + F.wave : ((int)blockIdx.x - (F.G - CCUS)) * NWAVES + F.wave, NGW = MODE == 0 ? F.G * NWAVES : CCUS * NWAVES;
    constexpr int I_IN = 32 * 192, I_O = 32 * 64, I_GU = 32 * 224, I_D = 112 * 64;
    constexpr int J_GU = 16 * 224, J_D = 56 * 64;
    constexpr int PER8 = 2 * J_GU + J_D, PER16 = 2 * I_GU + I_D, N8 = DENSE_FP8 ? 9 : 8;
    constexpr int NITEMS = NLAYER * (I_IN + I_O) + N8 * PER8 + (DENSE_FP8 ? 0 : PER16);
    const float* p_w_in = INP(w_in); const float* p_w_o = INP(w_o); const float* p_mg = INP(moba_out_g); const float* p_fg = INP(fox_out_g);
    const float* p_dg = INP(dense_w_gate); const float* p_du = INP(dense_w_up); const float* p_dd = INP(dense_w_down);
    const float* p_eg = INP(moe_w_gate); const float* p_eu = INP(moe_w_up); const float* p_ed = INP(moe_w_down);
    unsigned char* wsb = a.ws;
    struct Item { const float* src; unsigned char* dst; const float* ksc; int ldw, K, nload, map, fp8; float scale; };
    auto decode = [&](int it) -> Item {
        Item d; int r = it; d.ksc = nullptr; d.scale = 1.f; d.fp8 = 0; d.nload = 8;
        if (r < NLAYER * I_IN) { const int l = r / I_IN; r -= l * I_IN; const int kb = r / 192, nb = r - kb * 192;
            d.src = p_w_in + (size_t)l * DM * INW + (size_t)(64 * kb) * INW + 32 * nb; d.ldw = INW; d.K = DM; d.map = 1;
            d.dst = wsb + WS_WIN + ((size_t)l * NQKV * DM + 64 * kb) * 2; d.scale = __int_as_float(32 * nb); return d; }
        r -= NLAYER * I_IN;
        if (r < NLAYER * I_O) { const int l = r / I_O; r -= l * I_O; const int kb = r / 64, nb = r - kb * 64;
            d.src = p_w_o + (size_t)l * DM * DM + (size_t)(64 * kb) * DM + 32 * nb; d.ldw = DM; d.K = DM; d.map = 0;
            d.ksc = ((kb < 16) ? p_mg + l * 1024 : p_fg + l * 1024 - 1024) + 64 * kb;
            d.dst = wsb + WS_WO + ((size_t)l * DM * DM + 64 * kb) * 2; d.scale = __int_as_float(32 * nb); return d; }
        r -= NLAYER * I_O;
        if (r < N8 * PER8) { int e = r / PER8; r -= e * PER8; if (!DENSE_FP8) e += 1;
            d.fp8 = 1; d.nload = 16;
            unsigned char* wgu8 = e ? wsb + WS_WGU8 + (size_t)(e - 1) * NGU * DM : wsb + WS_WGU;
            unsigned char* wd8 = e ? wsb + WS_WD8 + (size_t)(e - 1) * DM * DFF : wsb + WS_WD;
            if (r < 2 * J_GU) { const int up = r >= J_GU; if (up) r -= J_GU; const int kb = r / 224, nb = r - kb * 224;
                const float* sp = up ? (e == 0 ? p_du : p_eu + (size_t)(e - 1) * DM * DFF) : (e == 0 ? p_dg : p_eg + (size_t)(e - 1) * DM * DFF);
                d.src = sp + (size_t)(128 * kb) * DFF + 32 * nb; d.ldw = DFF; d.K = DM; d.map = up ? 3 : 2; d.dst = wgu8 + 128 * kb; d.ksc = nullptr; d.scale = __int_as_float(32 * nb); d.fp8 = 1 + 64; return d; }
            r -= 2 * J_GU; { const int kb = r / 64, nb = r - kb * 64; const float* sp = e == 0 ? p_dd : p_ed + (size_t)(e - 1) * DM * DFF;
                d.src = sp + (size_t)(128 * kb) * DM + 32 * nb; d.ldw = DM; d.K = DFF; d.map = 0; d.dst = wd8 + 128 * kb; d.scale = __int_as_float(32 * nb); d.fp8 = 1 + 128; return d; } }
        r -= N8 * PER8;
        if (r < 2 * I_GU) { const int up = r >= I_GU; if (up) r -= I_GU; const int kb = r / 224, nb = r - kb * 224;
            d.src = (up ? p_du : p_dg) + (size_t)(64 * kb) * DFF + 32 * nb; d.ldw = DFF; d.K = DM; d.map = up ? 3 : 2; d.dst = wsb + WS_WGU + (size_t)(64 * kb) * 2; d.scale = __int_as_float(32 * nb); return d; }
        r -= 2 * I_GU; { const int kb = r / 64, nb = r - kb * 64;
            d.src = p_dd + (size_t)(64 * kb) * DM + 32 * nb; d.ldw = DM; d.K = DFF; d.map = 0; d.dst = wsb + WS_WD + (size_t)(64 * kb) * 2; d.scale = __int_as_float(32 * nb); return d; }
    };
    auto load = [&](const Item& d, f32x4 (&buf)[16]) {
        const float* s = d.src + (size_t)(F.lane >> 3) * d.ldw + (F.lane & 7) * 4;
#pragma unroll
        for (int i = 0; i < 8; ++i) buf[i] = (MODE != 0 && CONV_NT) ? __builtin_nontemporal_load((const GAS f32x4*)(s + (size_t)(8 * i) * d.ldw)) : *(const GAS f32x4*)(s + (size_t)(8 * i) * d.ldw);
        if (d.nload == 16) {
#pragma unroll
            for (int i = 8; i < 16; ++i) buf[i] = (MODE != 0 && CONV_NT) ? __builtin_nontemporal_load((const GAS f32x4*)(s + (size_t)(8 * i) * d.ldw)) : *(const GAS f32x4*)(s + (size_t)(8 * i) * d.ldw); }
    };
    auto mapr = [&](int map, int c) -> int {
        if (map == 1) { if (c >= 2048) return c; const int dd_ = c & 127, d6 = dd_ & 63; return (c & ~127) + 8 * (d6 >> 2) + 4 * (dd_ >> 6) + (d6 & 3); }
        if (map == 2) return (c >> 7) * 256 + (c & 127);
        if (map == 3) return (c >> 7) * 256 + 128 + (c & 127);
        return c; };
    auto process = [&](const Item& d, const f32x4 (&buf)[16]) {
        const int n0 = __float_as_int(d.scale), c4 = (F.lane & 7) * 4, c = F.lane & 7;
        if (d.fp8 & 1) {
            const float sc = (d.fp8 & 128) ? 128.f : 64.f;
#pragma unroll
            for (int i = 0; i < 16; ++i) { const int kk = 8 * i + (F.lane >> 3); const f32x4 v = buf[i] * sc; LAS float* q = scr + kk * 33 + c4; q[0] = v.x; q[1] = v.y; q[2] = v.z; q[3] = v.w; }
            LDS_WAIT(); asm volatile("" ::: "memory");
#pragma unroll
            for (int j = 0; j < 4; ++j) { const int n = (F.lane >> 3) + 8 * j; const LAS float* s = scr + (16 * c) * 33 + n;
                v4u o; o.x = pg8::pk_fp8x4(s[0 * 33], s[1 * 33], s[2 * 33], s[3 * 33]); o.y = pg8::pk_fp8x4(s[4 * 33], s[5 * 33], s[6 * 33], s[7 * 33]);
                o.z = pg8::pk_fp8x4(s[8 * 33], s[9 * 33], s[10 * 33], s[11 * 33]); o.w = pg8::pk_fp8x4(s[12 * 33], s[13 * 33], s[14 * 33], s[15 * 33]);
                if (MODE != 0 && CONV_NT) __builtin_nontemporal_store(o, (GAS v4u*)(d.dst + (size_t)mapr(d.map, n0 + n) * d.K + 16 * c)); else *(GAS v4u*)(d.dst + (size_t)mapr(d.map, n0 + n) * d.K + 16 * c) = o; }
        } else {
#pragma unroll
            for (int i = 0; i < 8; ++i) { const int kk = 8 * i + (F.lane >> 3); f32x4 v = buf[i]; if (d.ksc) v = v * d.ksc[kk]; LAS float* q = scr + kk * 33 + c4; q[0] = v.x; q[1] = v.y; q[2] = v.z; q[3] = v.w; }
            LDS_WAIT(); asm volatile("" ::: "memory");
#pragma unroll
            for (int j = 0; j < 4; ++j) { const int n = (F.lane >> 3) + 8 * j; const LAS float* s = scr + (8 * c) * 33 + n;
                v4u o; o.x = pg8::cvt_pk_bf16(s[0 * 33], s[1 * 33]); o.y = pg8::cvt_pk_bf16(s[2 * 33], s[3 * 33]); o.z = pg8::cvt_pk_bf16(s[4 * 33], s[5 * 33]); o.w = pg8::cvt_pk_bf16(s[6 * 33], s[7 * 33]);
                *(GAS v4u*)(d.dst + ((size_t)mapr(d.map, n0 + n) * d.K + 8 * c) * 2) = o; }
        }
        LDS_WAIT(); asm volatile("" ::: "memory");
    };
    f32x4 bufA[16], bufB[16]; Item cur, nxt;
    constexpr int EARLY0 = NLAYER * (I_IN + I_O) + (DENSE_FP8 ? PER8 : 0), EARLY = EARLY0 + (int)((long long)(NITEMS - EARLY0) * CONV_KEEP_PCT / 100), MID = EARLY + (int)((long long)(NITEMS - EARLY0) * CONV_A_PCT / 100);
    const bool sp = conv_split(F.G);
    const int lo = MODE == 0 ? 0 : MODE == 1 ? EARLY : MID, hi = MODE == 0 ? (sp ? EARLY : NITEMS) : MODE == 1 ? MID : NITEMS;
    int it = lo + gw;
    if (it < hi) { cur = decode(it); load(cur, bufA); }
    while (it < hi) {
        int nit = it + NGW; bool hn = nit < hi;
        if (hn) { nxt = decode(nit); load(nxt, bufB); }
        process(cur, bufA);
        if (!hn) break;
        it = nit; nit = it + NGW; hn = nit < hi;
        if (hn) { cur = decode(nit); load(cur, bufA); }
        process(nxt, bufB);
        if (!hn) break;
        it = nit;
    }
}
__device__ __forceinline__ float reduce8(const float (&v)[8], int lane) {
    float a[4], b[2], c;
    const bool u32 = (lane & 32) != 0, u16 = (lane & 16) != 0, u8 = (lane & 8) != 0;
#pragma unroll
    for (int i = 0; i < 4; ++i) { const float send = u32 ? v[i] : v[i + 4], keep = u32 ? v[i + 4] : v[i]; a[i] = keep + __shfl_xor(send, 32); }
#pragma unroll
    for (int i = 0; i < 2; ++i) { const float send = u16 ? a[i] : a[i + 2], keep = u16 ? a[i + 2] : a[i]; b[i] = keep + __shfl_xor(send, 16); }
    { const float send = u8 ? b[0] : b[1], keep = u8 ? b[1] : b[0]; c = keep + __shfl_xor(send, 8); }
    c += __shfl_xor(c, 4); c += __shfl_xor(c, 2); c += __shfl_xor(c, 1);
    return c;
}
template <int MODE, bool XB16>
__device__ __forceinline__ void norm_phase(Frame& F0, const Args& a, const void* xin_  , const float* g, const float* modl  , int shc  ,
                                           const float* aux  , const float* fb, bf16* H) {
    Frame F = F0; asm volatile("" : "+v"(F.tid), "+v"(F.lane));
    LAS float* A = (LAS float*)(F.lds + RING_OFF); LAS float* B = A + DM; LAS float* W = B + DM;
    LAS int* rt = (LAS int*)(W + 8 * DM);
    if (MODE == 0) { for (int i = F.tid; i < 2 * DM; i += NWAVES * 64) *(LAS f32x4*)(W + 4 * i) = *(const GAS f32x4*)(aux + 4 * i);
        float* ks = (float*)(a.ws + WS_KMEAN); for (int i = F.vcu * (NWAVES * 64) + F.tid; i < 32 * 16 * 128; i += F.G * NWAVES * 64) ks[i] = 0.f; }
    if (MODE == 1) { for (int d = F.tid; d < DM; d += NWAVES * 64) { const f32x4 r0 = *(const GAS f32x4*)(aux + 8 * d), r1 = *(const GAS f32x4*)(aux + 8 * d + 4);
            W[d] = r0.x; W[DM + d] = r0.y; W[2 * DM + d] = r0.z; W[3 * DM + d] = r0.w; W[4 * DM + d] = r1.x; W[5 * DM + d] = r1.y; W[6 * DM + d] = r1.z; W[7 * DM + d] = r1.w; } }
    constexpr bool F8OUT = (MODE == 1) || (MODE == 2 && DENSE_FP8);
    int lastb = -1;
    for (int chunk = F.vcu; chunk < NTOK / 64; chunk += F.G) {
        const int b = chunk >> 6;
        if (b != lastb) { __syncthreads();
            for (int i = F.tid; i < DM; i += NWAVES * 64) { A[i] = g[i] * (1.f + modl[(size_t)b * 12288 + (shc + 1) * DM + i]); B[i] = modl[(size_t)b * 12288 + shc * DM + i]; }
            lastb = b; }
        __syncthreads();
#pragma unroll 1
        for (int rp = 0; rp < 4; ++rp) {
            const int row0 = chunk * 64 + F.wave * 8 + rp * 2;
            f32x4 v[2][8]; float ss[2] = {0.f, 0.f};
            if (!XB16) {
#pragma unroll
                for (int r2 = 0; r2 < 2; ++r2) { const GAS f32x4* xr = (const GAS f32x4*)((const float*)xin_ + (size_t)(row0 + r2) * DM) + F.lane;
#pragma unroll
                    for (int j = 0; j < 8; ++j) v[r2][j] = xr[64 * j]; }
            } else { v2u w[2][8];
#pragma unroll
                for (int r2 = 0; r2 < 2; ++r2) { const GAS v2u* xr = (const GAS v2u*)((const bf16*)xin_ + (size_t)(row0 + r2) * DM) + F.lane;
#pragma unroll
                    for (int j = 0; j < 8; ++j) w[r2][j] = xr[64 * j]; }
#pragma unroll
                for (int r2 = 0; r2 < 2; ++r2)
#pragma unroll
                    for (int j = 0; j < 8; ++j) v[r2][j] = (f32x4){__builtin_bit_cast(float, w[r2][j].x << 16), __builtin_bit_cast(float, w[r2][j].x & 0xffff0000u), __builtin_bit_cast(float, w[r2][j].y << 16), __builtin_bit_cast(float, w[r2][j].y & 0xffff0000u)};
            }
#pragma unroll
            for (int r2 = 0; r2 < 2; ++r2)
#pragma unroll
                for (int j = 0; j < 8; ++j) ss[r2] += (v[r2][j].x * v[r2][j].x + v[r2][j].y * v[r2][j].y) + (v[r2][j].z * v[r2][j].z + v[r2][j].w * v[r2][j].w);
#pragma unroll
            for (int o = 1; o < 64; o <<= 1) { ss[0] += __shfl_xor(ss[0], o); ss[1] += __shfl_xor(ss[1], o); }
#pragma unroll
            for (int r2 = 0; r2 < 2; ++r2) {
                const int row = row0 + r2; const float rstd = 1.0f / sqrtf(ss[r2] * (1.f / DM) + EPS);
#pragma unroll
                for (int j = 0; j < 8; ++j) { const f32x4 av = *(const LAS f32x4*)(A + 256 * j + 4 * F.lane), bv = *(const LAS f32x4*)(B + 256 * j + 4 * F.lane);
                    v[r2][j] = v[r2][j] * rstd * av + bv;
                    if (F8OUT) ((GAS unsigned*)((unsigned char*)H + (size_t)row * DM))[64 * j + F.lane] = pg8::pk_fp8x4(v[r2][j].x, v[r2][j].y, v[r2][j].z, v[r2][j].w);
                    else { v2u w; w.x = pg8::cvt_pk_bf16(v[r2][j].x, v[r2][j].y); w.y = pg8::cvt_pk_bf16(v[r2][j].z, v[r2][j].w); ((GAS v2u*)(H + (size_t)row * DM) + F.lane)[64 * j] = w; } }
            }
            float t2[2][8];
            if (MODE != 2) {
                f32x4 wq[2][8];
#pragma unroll
                for (int j = 0; j < 8; ++j) wq[0][j] = *(const LAS f32x4*)(W + 256 * j + 4 * F.lane);
#pragma unroll
                for (int e = 0; e < 8; ++e) { f32x4 s0 = {0.f, 0.f, 0.f, 0.f}, s1 = s0;
                    __builtin_amdgcn_sched_barrier(0);
                    if (e + 1 < 8) {
#pragma unroll
                        for (int j = 0; j < 8; ++j) wq[(e + 1) & 1][j] = *(const LAS f32x4*)(W + (e + 1) * DM + 256 * j + 4 * F.lane); }
                    __builtin_amdgcn_sched_barrier(0);
#pragma unroll
                    for (int j = 0; j < 8; ++j) { s0 += v[0][j] * wq[e & 1][j]; s1 += v[1][j] * wq[e & 1][j]; }
                    t2[0][e] = (s0.x + s0.y) + (s0.z + s0.w); t2[1][e] = (s1.x + s1.y) + (s1.z + s1.w);
                    asm volatile("" : "+v"(t2[0][e]), "+v"(t2[1][e])); }
                __builtin_amdgcn_sched_barrier(0);
            }
#pragma unroll
            for (int r2 = 0; r2 < 2; ++r2) {
                const int row = row0 + r2;
                if (MODE != 2) {
                    const float tot = reduce8(t2[r2], F.lane);
                    if (MODE == 0) {
                        if ((F.lane & 7) == 0) { const int hh = F.lane >> 3; const float z = tot + fb[hh]; const float ls = fminf(z, 0.f) - log1pf(expf(-fabsf(z)));
                            ((float*)(a.ws + WS_LOGF))[((size_t)b * 8 + hh) * SEQ + (row & (SEQ - 1))] = ls; }
                    } else {
                        float lg[8];
#pragma unroll
                        for (int e = 0; e < 8; ++e) lg[e] = __uint_as_float((unsigned)__builtin_amdgcn_readlane((int)__float_as_uint(tot), 8 * e));
                        int i0 = 0, i1 = 0; float v0 = -__builtin_inff(), v1 = -__builtin_inff();
#pragma unroll
                        for (int e = 0; e < 8; ++e) if (lg[e] > v0) { v0 = lg[e]; i0 = e; }
#pragma unroll
                        for (int e = 0; e < 8; ++e) if (e != i0 && lg[e] > v1) { v1 = lg[e]; i1 = e; }
                        const float e1 = expf(v1 - v0), w0 = 1.f / (1.f + e1), w1 = e1 / (1.f + e1);
                        if (F.lane == 0) { int* te = (int*)(a.ws + WS_ROUTE); float* tw = (float*)(a.ws + WS_ROUTE + 131072);
                            te[row * 2] = i0; te[row * 2 + 1] = i1; tw[row * 2] = w0; tw[row * 2 + 1] = w1; rt[(row & 63) * 2] = i0; rt[(row & 63) * 2 + 1] = i1; }
                    }
                }
            }
        }
        if (MODE == 1) {
            __syncthreads();
            if (F.wave == 0) { const int e0 = rt[F.lane * 2], e1 = rt[F.lane * 2 + 1]; int r0 = 0, r1 = 0;
                int* rk = (int*)(a.ws + WS_ROUTE + 2 * 131072); int* cnt = (int*)(a.ws + WS_ROUTE + 4 * 131072);
#pragma unroll
                for (int e = 0; e < 8; ++e) { const unsigned long long bal = __ballot(e0 == e || e1 == e); const int pre = __popcll(bal & ((1ull << F.lane) - 1ull));
                    if (e0 == e) r0 = pre; if (e1 == e) r1 = pre; if (F.lane == 0) cnt[chunk * 8 + e] = __popcll(bal); }
                rk[(chunk * 64 + F.lane) * 2] = r0; rk[(chunk * 64 + F.lane) * 2 + 1] = r1; }
        }
    }
    __syncthreads();
}
__device__ __forceinline__ void outnorm_phase(Frame& F0, const Args& a) {
    Frame F = F0; asm volatile("" : "+v"(F.tid), "+v"(F.lane));
    bf16* ob = (bf16*)(a.ws + WS_O);
    for (int row = F.vcu * NWAVES + F.wave; row < NTOK; row += F.G * NWAVES) {
        GAS v4u* p = (GAS v4u*)(ob + (size_t)row * DM) + F.lane; v4u w[4]; float f[4][8]; float ss0 = 0.f, ss1 = 0.f;
#pragma unroll
        for (int j = 0; j < 4; ++j) w[j] = p[64 * j];
#pragma unroll
        for (int j = 0; j < 4; ++j) { const unsigned u4[4] = {w[j].x, w[j].y, w[j].z, w[j].w}; float s = 0.f;
#pragma unroll
            for (int q = 0; q < 4; ++q) { f[j][2 * q] = bf2f((unsigned short)(u4[q] & 0xffffu)); f[j][2 * q + 1] = bf2f((unsigned short)(u4[q] >> 16)); s += f[j][2 * q] * f[j][2 * q] + f[j][2 * q + 1] * f[j][2 * q + 1]; }
            if (j < 2) ss0 += s; else ss1 += s; }
        const float r0 = 1.0f / sqrtf(wave_sum(ss0) * (1.f / 1024.f) + EPS), r1 = 1.0f / sqrtf(wave_sum(ss1) * (1.f / 1024.f) + EPS);
#pragma unroll
        for (int j = 0; j < 4; ++j) { const float r = j < 2 ? r0 : r1; v4u o; o.x = pk2(f[j][0] * r, f[j][1] * r); o.y = pk2(f[j][2] * r, f[j][3] * r); o.z = pk2(f[j][4] * r, f[j][5] * r); o.w = pk2(f[j][6] * r, f[j][7] * r); p[64 * j] = o; }
    }
}
__device__ __forceinline__ void moe_gather_phase(Frame& F0, const Args& a) {
    Frame F = F0; asm volatile("" : "+v"(F.tid), "+v"(F.lane));
    LAS int* tile_e = (LAS int*)(F.lds + TILE_E_OFF);
    LAS int* sh = (LAS int*)(F.lds + RING_OFF);
    const int* cnt = (const int*)(a.ws + WS_ROUTE + 4 * 131072); const int* te = (const int*)(a.ws + WS_ROUTE); const int* rk = (const int*)(a.ws + WS_ROUTE + 2 * 131072);
    int* slot = (int*)(a.ws + WS_ROUTE + 3 * 131072);
    const bf16* H = (const bf16*)(a.ws + WS_H); bf16* HS = (bf16*)(a.ws + WS_HS);
    for (int chunk = F.vcu; chunk < NTOK / 64; chunk += F.G) {
        __syncthreads();
        if (F.wave == 0) {
            int tot[8], bef[8];
#pragma unroll
            for (int e = 0; e < 8; ++e) { tot[e] = 0; bef[e] = 0; }
            for (int c = F.lane; c < 256; c += 64) {
#pragma unroll
                for (int e = 0; e < 8; ++e) { const int v = cnt[c * 8 + e]; tot[e] += v; if (c < chunk) bef[e] += v; } }
#pragma unroll
            for (int e = 0; e < 8; ++e) {
#pragma unroll
                for (int o = 1; o < 64; o <<= 1) { tot[e] += __shfl_xor(tot[e], o); bef[e] += __shfl_xor(bef[e], o); } }
            if (F.lane == 0) { int off = 0;
#pragma unroll
                for (int e = 0; e < 8; ++e) { sh[e] = tot[e]; sh[8 + e] = off; sh[32 + e] = bef[e]; const int nt = (tot[e] + 255) >> 8;
                    for (int t = 0; t < nt; ++t) tile_e[(off >> 8) + t] = e; off += nt << 8; }
                sh[16] = off; tile_e[140] = off >> 8; }
        }
        __syncthreads();
        LAS int* sl = sh + 64;
        if (F.wave == 0) { const int t = chunk * 64 + F.lane;
#pragma unroll
            for (int k = 0; k < 2; ++k) { const int e = te[t * 2 + k]; const int s = sh[8 + e] + sh[32 + e] + rk[t * 2 + k]; slot[t * 2 + k] = s; sl[F.lane * 2 + k] = s; } }
        __syncthreads();
        for (int cp0 = F.wave; cp0 < 128; cp0 += 4 * NWAVES) {
            v4u w[4][2];
#pragma unroll
            for (int q = 0; q < 4; ++q) { const int cp = cp0 + q * NWAVES, tl = cp >> 1; const GAS v4u* src = (const GAS v4u*)((const unsigned char*)H + (size_t)(chunk * 64 + tl) * DM) + F.lane;
#pragma unroll
                for (int j = 0; j < 2; ++j) w[q][j] = src[64 * j]; }
#pragma unroll
            for (int q = 0; q < 4; ++q) { const int s = sl[cp0 + q * NWAVES]; GAS v4u* dst = (GAS v4u*)((unsigned char*)HS + (size_t)s * DM) + F.lane;
#pragma unroll
                for (int j = 0; j < 2; ++j) dst[64 * j] = w[q][j]; } }
    }
    __syncthreads();
}
__device__ __forceinline__ void final_phase(Frame& F0, const Args& a, const bf16* x1  , const float* gf  , float* outp) {
    Frame F = F0; asm volatile("" : "+v"(F.tid), "+v"(F.lane));
    const float* fng = INP(final_norm_g);
    const LAS int* tile_e_ = (const LAS int*)(F.lds + TILE_E_OFF); const int nM_ = __builtin_amdgcn_readfirstlane(tile_e_[140]);
    const int nR_ = MOE_SPLIT ? nM_ % 32 : 0, nF256 = (nM_ - nR_) * 256, SS_ = nR_ ? moe_split_s(nR_, F.G) : 1; const float* YP = (const float*)(a.ws + WS_YP);
    const bf16* YS = (const bf16*)(a.ws + WS_YS); const int* slot = (const int*)(a.ws + WS_ROUTE + 3 * 131072); const float* tw = (const float*)(a.ws + WS_ROUTE + 131072);
    f32x4 fgv[8];
#pragma unroll
    for (int j = 0; j < 4; ++j) { fgv[2 * j] = ((const GAS f32x4*)fng)[128 * j + 2 * F.lane]; fgv[2 * j + 1] = ((const GAS f32x4*)fng)[128 * j + 2 * F.lane + 1]; }
    const int stride = F.G * NWAVES, rowA = F.vcu * NWAVES + F.wave;
    int sa0 = slot[rowA * 2], sa1 = slot[rowA * 2 + 1]; float wa0 = tw[rowA * 2], wa1 = tw[rowA * 2 + 1];
    int sb0 = 0, sb1 = 0; float wb0 = 0.f, wb1 = 0.f;
    if (rowA + stride < NTOK) { const int r_ = rowA + stride; sb0 = slot[r_ * 2]; sb1 = slot[r_ * 2 + 1]; wb0 = tw[r_ * 2]; wb1 = tw[r_ * 2 + 1]; }
    v4u xw[4], yv[2][4]; f32x4 gv[8];
#define FINAL_LOADS(ROW, S0, S1) do { const GAS v4u* xr_ = (const GAS v4u*)(x1 + (size_t)(ROW) * DM) + F.lane; const GAS v4u* y0_ = (const GAS v4u*)(YS + (size_t)(S0) * DM) + F.lane; const GAS v4u* y1_ = (const GAS v4u*)(YS + (size_t)(S1) * DM) + F.lane; \
        const GAS f32x4* gp_ = (const GAS f32x4*)(gf + (size_t)((ROW) >> 12) * 12288); \
        _Pragma("unroll") for (int j = 0; j < 4; ++j) { xw[j] = xr_[64 * j]; yv[0][j] = y0_[64 * j]; yv[1][j] = y1_[64 * j]; } \
        _Pragma("unroll") for (int j = 0; j < 4; ++j) { gv[2 * j] = gp_[128 * j + 2 * F.lane]; gv[2 * j + 1] = gp_[128 * j + 2 * F.lane + 1]; } } while (0)
    FINAL_LOADS(rowA, sa0, sa1);
#pragma unroll 1
    for (int row = rowA; row < NTOK; row += stride) {
        f32x4 v[8]; float s = 0.f; float yy[4][8];
#pragma unroll
        for (int j = 0; j < 4; ++j) {
#pragma unroll
            for (int q = 0; q < 8; ++q) yy[j][q] = 0.f; }
#pragma unroll
        for (int k = 0; k < 2; ++k) {
            const int sk = k ? sa1 : sa0; const float wk = k ? wa1 : wa0;
            if (sk < nF256) {
#pragma unroll
                for (int j = 0; j < 4; ++j) { const unsigned u4[4] = {yv[k][j].x, yv[k][j].y, yv[k][j].z, yv[k][j].w};
#pragma unroll
                    for (int q = 0; q < 4; ++q) { yy[j][2 * q] += __builtin_bit_cast(float, u4[q] << 16) * wk; yy[j][2 * q + 1] += __builtin_bit_cast(float, u4[q] & 0xffff0000u) * wk; } }
            } else {
                for (int ks = 0; ks < SS_; ++ks) { const GAS f32x4* pr = (const GAS f32x4*)(YP + ((size_t)ks * nR_ * 256 + (sk - nF256)) * DM);
#pragma unroll
                    for (int j = 0; j < 4; ++j) { const f32x4 p0 = pr[128 * j + 2 * F.lane], p1 = pr[128 * j + 2 * F.lane + 1];
                        yy[j][0] += p0.x * wk; yy[j][1] += p0.y * wk; yy[j][2] += p0.z * wk; yy[j][3] += p0.w * wk; yy[j][4] += p1.x * wk; yy[j][5] += p1.y * wk; yy[j][6] += p1.z * wk; yy[j][7] += p1.w * wk; } }
            }
        }
#pragma unroll
        for (int j = 0; j < 4; ++j) { const float (&y)[8] = yy[j]; const v4u w = xw[j];
            const f32x4 xa = {__builtin_bit_cast(float, w.x << 16), __builtin_bit_cast(float, w.x & 0xffff0000u), __builtin_bit_cast(float, w.y << 16), __builtin_bit_cast(float, w.y & 0xffff0000u)};
            const f32x4 xb = {__builtin_bit_cast(float, w.z << 16), __builtin_bit_cast(float, w.z & 0xffff0000u), __builtin_bit_cast(float, w.w << 16), __builtin_bit_cast(float, w.w & 0xffff0000u)};
            v[2 * j] = xa + gv[2 * j] * (f32x4){y[0], y[1], y[2], y[3]}; v[2 * j + 1] = xb + gv[2 * j + 1] * (f32x4){y[4], y[5], y[6], y[7]};
            s += (v[2 * j].x * v[2 * j].x + v[2 * j].y * v[2 * j].y) + (v[2 * j].z * v[2 * j].z + v[2 * j].w * v[2 * j].w) + (v[2 * j + 1].x * v[2 * j + 1].x + v[2 * j + 1].y * v[2 * j + 1].y) + (v[2 * j + 1].z * v[2 * j + 1].z + v[2 * j + 1].w * v[2 * j + 1].w); }
        __builtin_amdgcn_sched_barrier(0);
        { const int nr = row + stride;
          if (nr < NTOK) { FINAL_LOADS(nr, sb0, sb1); }
          sa0 = sb0; sa1 = sb1; wa0 = wb0; wa1 = wb1;
          const int nnr = nr + stride; if (nnr < NTOK) { sb0 = slot[nnr * 2]; sb1 = slot[nnr * 2 + 1]; wb0 = tw[nnr * 2]; wb1 = tw[nnr * 2 + 1]; } }
        __builtin_amdgcn_sched_barrier(0);
        const float rstd = 1.0f / sqrtf(wave_sum(s) * (1.f / DM) + EPS);
        GAS f32x4* o = (GAS f32x4*)(outp + (size_t)row * DM);
#pragma unroll
        for (int j = 0; j < 4; ++j) { o[128 * j + 2 * F.lane] = v[2 * j] * rstd * fgv[2 * j]; o[128 * j + 2 * F.lane + 1] = v[2 * j + 1] * rstd * fgv[2 * j + 1]; }
    }
#undef FINAL_LOADS
}

#ifndef REP_NORM3
#define REP_NORM3 1
#endif
#ifndef REP_FINAL
#define REP_FINAL 1
#endif
#ifndef REP_NORM2
#define REP_NORM2 1
#endif
#ifndef EXTRA_BARS
#define EXTRA_BARS 0
#endif
#ifndef REP_P0
#define REP_P0 1
#endif
#ifndef REP_INPROJ
#define REP_INPROJ 1
#endif
#ifndef REP_ATTN
#define REP_ATTN 1
#endif
#ifndef REP_WO
#define REP_WO 1
#endif
#ifndef REP_DUP
#define REP_DUP 1
#endif
#ifndef REP_DDOWN
#define REP_DDOWN 1
#endif
#ifndef REP_MUP
#define REP_MUP 1
#endif
#ifndef REP_MDOWN
#define REP_MDOWN 1
#endif
#ifndef REP_NORM1
#define REP_NORM1 1
#endif
#ifndef REP_SCAN
#define REP_SCAN 1
#endif
#ifndef REP_OUTNORM
#define REP_OUTNORM 1
#endif
#ifndef REP_GATHER
#define REP_GATHER 1
#endif
#ifndef PH_P0
#define PH_P0 1
#endif
#ifndef PH_NORM1
#define PH_NORM1 1
#endif
#ifndef PH_INPROJ
#define PH_INPROJ 1
#endif
#ifndef PH_SCAN
#define PH_SCAN 1
#endif
#ifndef PH_MOBA
#define PH_MOBA 1
#endif
#ifndef PH_FOX
#define PH_FOX 1
#endif
#ifndef PH_OUTNORM
#define PH_OUTNORM 1
#endif
#ifndef PH_WO
#define PH_WO 1
#endif
#ifndef PH_NORM2
#define PH_NORM2 1
#endif
#ifndef PH_DUP
#define PH_DUP 1
#endif
#ifndef PH_DDOWN
#define PH_DDOWN 1
#endif
#ifndef PH_NORM3
#define PH_NORM3 1
#endif
#ifndef PH_GATHER
#define PH_GATHER 1
#endif
#ifndef PH_MUP
#define PH_MUP 1
#endif
#ifndef PH_MDOWN
#define PH_MDOWN 1
#endif
#ifndef PH_FINAL
#define PH_FINAL 1
#endif
template <int l>
__device__ __forceinline__ void layer_body(Frame& F, const Args& args, const XcdBarrier& bar) {
    unsigned char* ws = args.ws;
    bf16* H = (bf16*)(ws + WS_H); bf16* QKV = (bf16*)(ws + WS_QKV); bf16* OB = (bf16*)(ws + WS_O);
    const float* mod = (const float*)(ws + WS_MOD);
#define GRID_BAR() xcd_barrier(bar)
        const float* modl = mod + (size_t)l * NB * 12288;
        bf16* XB = (bf16*)(ws + WS_XB);
        const void* xin = (l == 0) ? (const void*)inp(ws, I_x) : (const void*)XB;
#if PH_NORM1
for (int rep_ = 0; rep_ < REP_NORM1; ++rep_) {
        norm_phase<0, l != 0>(F, args, xin, inp(ws, I_attn_norm_g) + l * DM, modl, 0, (const float*)(ws + WS_WFZ) + (size_t)l * 8 * DM, inp(ws, I_forget_b) + l * 8, H);
#endif
        GRID_BAR();
}
#if PH_INPROJ
for (int rep_ = 0; rep_ < REP_INPROJ; ++rep_) {
        if (l == 0 && conv_split(F.G) && (int)blockIdx.x >= F.G - CONV_CUS_A) p0b<1>(F, args);
        else { const int Gg = (l == 0 && conv_split(F.G)) ? F.G - CONV_CUS_A : F.G;
          pg8::Gemm g{H, (const bf16*)(ws + WS_WIN) + (size_t)l * NQKV * DM, NTOK, NQKV, DM, 0, 0}; pg8::StaticOrder S; S.init(NTOK, NQKV, Gg, (int)blockIdx.x, WGM_INPROJ);
          pg8::EpiQKV E{QKV, NQKV, (const float*)(ws + WS_ROPE), (float*)(ws + WS_KMEAN)};
          pg8::gemm_phase<pg8::EpiQKV, pg8::StaticOrder, true, true>(F.lds + RING_OFF, g, S, E); }
#endif
        GRID_BAR();
}

for (int rep_ = 0; rep_ < REP_ATTN; ++rep_) {
        { const att::Tensors T{QKV, OB, (const float*)(ws + WS_LOGF), (const float*)(ws + WS_KMEAN), (float*)(ws + WS_FBIAS)};
#if PH_MOBA
          att::attn_phase<0>((LAS char*)(F.lds + RING_OFF), T, F.vcu, F.G);
#endif
#if PH_FOX
          att::attn_phase<1>((LAS char*)(F.lds + RING_OFF), T, F.vcu, F.G);
#endif
          (void)T; }
        GRID_BAR();
}

#if PH_WO
for (int rep_ = 0; rep_ < REP_WO; ++rep_) {
        { pg8::Gemm g{OB, (const bf16*)(ws + WS_WO) + (size_t)l * DM * DM, NTOK, DM, DM, 0, 0}; pg8::StaticOrder S; S.init(NTOK, DM, F.G, (int)blockIdx.x, WGM_WO);
          LAS float* rs = (LAS float*)(F.lds + RS_OFF);
          { int tid_ = F.tid; asm volatile("" : "+v"(tid_)); pg8::Unit uu; const float* ssq = (const float*)(ws + WS_FBIAS);
            for (int i = 0; i < RS_UNITS; ++i) if (S.next(i, uu) && tid_ < 256) { const f32x4* q = (const f32x4*)(ssq + (size_t)(uu.pm * 256 + tid_) * 16); const f32x4 a0 = q[0], a1 = q[1], a2 = q[2], a3 = q[3];
                const float sm = ((a0[0] + a0[1]) + (a0[2] + a0[3])) + ((a1[0] + a1[1]) + (a1[2] + a1[3])), sf = ((a2[0] + a2[1]) + (a2[2] + a2[3])) + ((a3[0] + a3[1]) + (a3[2] + a3[3]));
                const float rf = 1.0f / sqrtf(sf * (1.f / 1024.f) + EPS), rm = 1.0f / sqrtf(sm * (1.f / 1024.f) + EPS);
                rs[(i * 256 + tid_) * 2] = rm / rf; rs[(i * 256 + tid_) * 2 + 1] = rf; }
            __syncthreads(); }
          pg8::EpiResidB<l == 0, true> E{xin, rep_ ? (bf16*)(ws + WS_YS) : XB, modl + 2 * DM, 1.f, rs};
          pg8::gemm_phase<pg8::EpiResidB<l == 0, true>, pg8::StaticOrder, true, true>(F.lds + RING_OFF, g, S, E); }
#endif
        GRID_BAR();
}
        if (l == 0) {
#if PH_NORM2
for (int rep_ = 0; rep_ < REP_NORM2; ++rep_) {
            norm_phase<2, true>(F, args, XB, inp(ws, I_ffn_norm_g) + l * DM, modl, 3, nullptr, nullptr, H);
#endif
            GRID_BAR();
}
for (int xb_ = 0; xb_ < EXTRA_BARS; ++xb_) GRID_BAR();
#if PH_DUP
for (int rep_ = 0; rep_ < REP_DUP; ++rep_) {
#if DENSE_FP8
            if (conv_split(F.G) && (int)blockIdx.x >= F.G - CONV_CUS_B) p0b<2>(F, args);
            else { const int Gg = conv_split(F.G) ? F.G - CONV_CUS_B : F.G;
              pg8::Gemm g{H, (const bf16*)(ws + WS_WGU), NTOK, NGU, DM / 2, 0, 0}; pg8::StaticOrder S; S.init(NTOK, NGU, Gg, (int)blockIdx.x, WGM_DUP);
              pg8::EpiSwiGLU8 E{(unsigned char*)(ws + WS_ACT), DFF, 1.f / 64.f};
              pg8::gemm_phase<pg8::EpiSwiGLU8, pg8::StaticOrder, true, true, true>(F.lds + RING_OFF, g, S, E); }
#else
            { pg8::Gemm g{H, (const bf16*)(ws + WS_WGU), NTOK, NGU, DM, 0, 0}; pg8::StaticOrder S; S.init(NTOK, NGU, F.G, (int)blockIdx.x, WGM_DUP);
              pg8::EpiSwiGLU E{(bf16*)(ws + WS_ACT), DFF};
              pg8::gemm_phase<pg8::EpiSwiGLU, pg8::StaticOrder, true, true>(F.lds + RING_OFF, g, S, E); }
#endif
#endif
            GRID_BAR();
}
#if PH_DDOWN
for (int rep_ = 0; rep_ < REP_DDOWN; ++rep_) {
#if DENSE_FP8
            { pg8::Gemm g{(const bf16*)(ws + WS_ACT), (const bf16*)(ws + WS_WD), NTOK, DM, DFF / 2, 0, 0}; pg8::StaticOrder S; S.init(NTOK, DM, F.G, (int)blockIdx.x, WGM_DDOWN);
              pg8::EpiResidB<false, false> E{XB, rep_ ? (bf16*)(ws + WS_YS) : XB, modl + 5 * DM, 1.f / 128.f, nullptr};
              pg8::gemm_phase<pg8::EpiResidB<false, false>, pg8::StaticOrder, true, true, true>(F.lds + RING_OFF, g, S, E); }
#else
            { pg8::Gemm g{(const bf16*)(ws + WS_ACT), (const bf16*)(ws + WS_WD), NTOK, DM, DFF, 0, 0}; pg8::StaticOrder S; S.init(NTOK, DM, F.G, (int)blockIdx.x, WGM_DDOWN);
              pg8::EpiResidB<false, false> E{XB, rep_ ? (bf16*)(ws + WS_YS) : XB, modl + 5 * DM, 1.f, nullptr};
              pg8::gemm_phase<pg8::EpiResidB<false, false>, pg8::StaticOrder, true, true>(F.lds + RING_OFF, g, S, E); }
#endif
#endif
            GRID_BAR();
}
        } else {
#if PH_NORM3
for (int rep_ = 0; rep_ < REP_NORM3; ++rep_) {
            norm_phase<1, true>(F, args, XB, inp(ws, I_ffn_norm_g) + l * DM, modl, 3, inp(ws, I_router_w), nullptr, H);
#endif
            GRID_BAR();
}
#if PH_GATHER
for (int rep_ = 0; rep_ < REP_GATHER; ++rep_) {
            moe_gather_phase(F, args);
#endif
            GRID_BAR();
}
            const LAS int* tile_e = (const LAS int*)(F.lds + TILE_E_OFF); const int nM = __builtin_amdgcn_readfirstlane(tile_e[140]);
#if PH_MUP
for (int rep_ = 0; rep_ < REP_MUP; ++rep_) {
            { pg8::Gemm g{(const bf16*)(ws + WS_HS), (const bf16*)(ws + WS_WGU8), MOE_ROWS, NGU, DM / 2, (size_t)NGU * DM, 0}; pg8::MoeOrder S; S.init(nM, NGU, F.G, (int)blockIdx.x, tile_e, WGM_MUP);
              pg8::EpiSwiGLU8 E{(unsigned char*)(ws + WS_ACTM), DFF, 1.f / 64.f};
              pg8::gemm_phase<pg8::EpiSwiGLU8, pg8::MoeOrder, true, true, true>(F.lds + RING_OFF, g, S, E); }
#endif
            GRID_BAR();
}
#if PH_MDOWN
for (int rep_ = 0; rep_ < REP_MDOWN; ++rep_) {
            { const int nR = MOE_SPLIT ? nM % 32 : 0, nF = nM - nR;
              if (nF > 0) { pg8::Gemm g{(const bf16*)(ws + WS_ACTM), (const bf16*)(ws + WS_WD8), MOE_ROWS, DM, DFF / 2, (size_t)DM * DFF, 0}; pg8::MoeOrder S; S.init(nF, DM, F.G, (int)blockIdx.x, tile_e, WGM_MDOWN);
                pg8::EpiBf16S E{(bf16*)(ws + WS_YS), DM, 1.f / 128.f};
                pg8::gemm_phase<pg8::EpiBf16S, pg8::MoeOrder, true, true, true>(F.lds + RING_OFF, g, S, E); }
              if (nR > 0) { const int SS = moe_split_s(nR, F.G);
                pg8::Gemm g{(const bf16*)(ws + WS_ACTM), (const bf16*)(ws + WS_WD8), MOE_ROWS, DM, DFF / 2, (size_t)DM * DFF, 56 / SS};
                pg8::MoeSplitOrder S{nF, nR, SS, F.G, (int)blockIdx.x, (unsigned)(56 / SS) * 128u, tile_e};
                pg8::EpiF32P E{(float*)(ws + WS_YP), nF, nR, 1.f / 128.f};
                pg8::gemm_phase<pg8::EpiF32P, pg8::MoeSplitOrder, true, true, true>(F.lds + RING_OFF, g, S, E); } }
#endif
            GRID_BAR();
}
#if PH_FINAL
for (int rep_ = REP_FINAL - 1; rep_ >= 0; --rep_) {
            final_phase(F, args, XB, modl + 5 * DM, rep_ ? (float*)(ws + WS_ACTM) : args.out);
 if (rep_) GRID_BAR(); }
#endif
        }
#undef GRID_BAR
}
__global__ void __launch_bounds__(NWAVES * 64, 2) mk_fwd(Args args) {
    extern __shared__ __attribute__((aligned(16))) unsigned char lds[];
    Frame F;
    F.lds = (LAS unsigned char*)lds; F.MISC = (volatile LAS unsigned*)(F.lds + MISC_OFF);
    F.tid = threadIdx.x; F.lane = F.tid & 63; F.wave = __builtin_amdgcn_readfirstlane(F.tid >> 6);
    F.G = gridDim.x; { const int bx = blockIdx.x; F.vcu = (F.G % 8 == 0) ? (bx % 8) * (F.G / 8) + bx / 8 : bx; }
    unsigned char* ws = args.ws;
    F.ctl = (gu32*)(ws + WS_CTL);
    for (int u = F.tid; u < (LDS_BYTES - LDSCTL_OFF) / 4; u += NWAVES * 64) ((LAS unsigned*)(F.lds + LDSCTL_OFF))[u] = 0u;
    __syncthreads();
    XcdBarrier bar = xcd_barrier_post((unsigned*)(F.ctl + CW_BAR), F.MISC + 8);
#define GRID_BAR() xcd_barrier(bar)
    bf16* H = (bf16*)(ws + WS_H); bf16* QKV = (bf16*)(ws + WS_QKV); bf16* OB = (bf16*)(ws + WS_O);
    const float* mod = (const float*)(ws + WS_MOD);

#if PH_P0
for (int rep_ = 0; rep_ < REP_P0; ++rep_) {
    p0a(F, args); GRID_BAR();
    p0b<0>(F, args); GRID_BAR();
}
#endif

    layer_body<0>(F, args, bar);
    layer_body<1>(F, args, bar);
}

extern "C" void kernel_launch(void* const* d_in, const int* in_sizes, int n_in, void* d_out, int out_size, void* d_ws, size_t ws_size, hipStream_t stream) {
    static int grid = 0;
    if (grid == 0) {
        if (n_in != 19 || out_size != NTOK * DM || ws_size < WS_END) { fprintf(stderr, "kernel_launch: unexpected shapes (n_in %d out %d ws %zu, need %zu); nothing launched\n", n_in, out_size, ws_size, (size_t)WS_END); grid = -1; return; }
        int dev = 0, cus = 0, per_cu = 0;
        if (hipGetDevice(&dev) != hipSuccess || hipDeviceGetAttribute(&cus, hipDeviceAttributeMultiprocessorCount, dev) != hipSuccess) { grid = -1; return; }
        if (hipFuncSetAttribute((const void*)mk_fwd, hipFuncAttributeMaxDynamicSharedMemorySize, LDS_BYTES) != hipSuccess) { fprintf(stderr, "kernel_launch: hipFuncSetAttribute failed\n"); grid = -1; return; }
        if (hipOccupancyMaxActiveBlocksPerMultiprocessor(&per_cu, (const void*)mk_fwd, NWAVES * 64, LDS_BYTES) != hipSuccess || per_cu < 1) fprintf(stderr, "kernel_launch: note: occupancy query reports %d\n", per_cu);
        (void)hipGetLastError();
        grid = cus;
    }
    if (grid < 0) return;
    if (hipMemsetAsync((char*)d_ws + WS_CTL + (size_t)CW_BAR * 4, 0, (size_t)XCD_BAR_WORDS * 4, stream) != hipSuccess) return;
    Args a{};
    for (int i = 0; i < N_IN; ++i) a.in[i] = (const float*)d_in[i];
    a.out = (float*)d_out; a.ws = (unsigned char*)d_ws;
    hipLaunchKernelGGL(mk_fwd, dim3(grid), dim3(NWAVES * 64), LDS_BYTES, stream, a);
}
```
